# Optimizing an MI355X kernel written in HIP

```python
import math
import jax
import jax.numpy as jnp
from jax import lax
import numpy as np

D_MODEL = 2048
BATCH = 4
SEQ = 2048
DEPTH = 4

HEAD_DIM = 128
NSA_HEADS = 8
NSA_KV_HEADS = 2
CMP_LEN = 32
CMP_STRIDE = 16
CMP_HIDDEN = 2 * HEAD_DIM
SEL_BLOCK = 64
SEL_TOP_N = 16
NSA_WINDOW = 512
NSA_Q_CHUNK = 64
SWA_HEADS = 8
SWA_KV_HEADS = 2
SWA_WINDOW = 128
MOBA_HEADS = 8
MOBA_KV_HEADS = 2
MOBA_BLOCK = 256
MOBA_TOP_K = 3
MOBA_Q_CHUNK = 16
BAND_BLOCK = 128
N_BUCKETS = 32
BUCKET_MAX_DIST = 128
TOTAL_HEADS = NSA_HEADS + SWA_HEADS + MOBA_HEADS
N_BRANCHES = 3
MIX_WIDTH = NSA_HEADS * HEAD_DIM
D_FF = 4 * D_MODEL
RMS_EPS = 1e-6
NEG_INF = -1e30
FORCE_SCORE = 1e30
TINY = 1e-30

SPLIT_SIZES = (
    NSA_HEADS * HEAD_DIM,
    NSA_KV_HEADS * HEAD_DIM,
    NSA_KV_HEADS * HEAD_DIM,
    NSA_KV_HEADS * HEAD_DIM,
    NSA_KV_HEADS * HEAD_DIM,
    NSA_KV_HEADS * HEAD_DIM,
    NSA_KV_HEADS * HEAD_DIM,
    NSA_HEADS * 3,
    SWA_HEADS * HEAD_DIM,
    SWA_KV_HEADS * HEAD_DIM,
    SWA_KV_HEADS * HEAD_DIM,
    MOBA_HEADS * HEAD_DIM,
    MOBA_KV_HEADS * HEAD_DIM,
    MOBA_KV_HEADS * HEAD_DIM,
    N_BRANCHES * D_MODEL,
)
SPLIT_POINTS = tuple(int(v) for v in np.cumsum(SPLIT_SIZES)[:-1])
D_IN = sum(SPLIT_SIZES)

kernel_name = 'hybrid_nsa_swa_moba_block'


def rms_norm(x, gain):
    x32 = x.astype(jnp.float32)
    y = x32 * lax.rsqrt(jnp.mean(x32 * x32, axis=-1, keepdims=True) + RMS_EPS)
    return (y * gain.astype(jnp.float32)).astype(x.dtype)


def t5_bucket(dist):
    n = jnp.maximum(dist, 0)
    exact = N_BUCKETS // 2
    log_ratio = jnp.log(jnp.maximum(n, 1).astype(jnp.float32) / exact) / math.log(BUCKET_MAX_DIST / exact)
    large = jnp.minimum(exact + (log_ratio * (N_BUCKETS - exact)).astype(jnp.int32), N_BUCKETS - 1)
    return jnp.where(n < exact, n, large)


def masked_softmax(logits, mask, sink=None):
    logits = jnp.where(mask, logits, NEG_INF)
    m = jnp.max(logits, axis=-1, keepdims=True)
    if sink is not None:
        m = jnp.maximum(m, sink)
    p = jnp.where(mask, jnp.exp(logits - m), 0.0)
    denom = jnp.sum(p, axis=-1, keepdims=True)
    if sink is not None:
        denom = denom + jnp.exp(sink - m)
    return p / jnp.maximum(denom, TINY)


def split_heads(t, n_heads):
    return t.reshape(t.shape[0], t.shape[1], n_heads, HEAD_DIM)


def banded_attention(q, k, v, bias_tbl, window, sinks=None):
    b, s, h, d = q.shape
    n_kv = k.shape[2]
    g = h // n_kv
    nb = s // BAND_BLOCK
    pad = -(-(window - 1) // BAND_BLOCK) * BAND_BLOCK
    span = BAND_BLOCK + pad
    key_idx = jnp.arange(nb)[:, None] * BAND_BLOCK + jnp.arange(span)[None, :]
    padding = ((0, 0), (pad, 0), (0, 0), (0, 0))
    kp = jnp.pad(k, padding)[:, key_idx]
    vp = jnp.pad(v, padding)[:, key_idx]
    qb = q.reshape(b, nb, BAND_BLOCK, n_kv, g, d)
    logits = jnp.einsum('bnqkgd,bnlkd->bnkgql', qb, kp, preferred_element_type=jnp.float32) * (d ** -0.5)
    dist = (jnp.arange(BAND_BLOCK)[:, None] + pad) - jnp.arange(span)[None, :]
    bias = jnp.transpose(bias_tbl[t5_bucket(dist)], (2, 0, 1)).reshape(n_kv, g, BAND_BLOCK, span)
    logits = logits + bias.astype(jnp.float32)
    mask = ((dist >= 0) & (dist < window))[None] & (key_idx >= pad)[:, None, :]
    mask = mask[None, :, None, None]
    sink = None
    if sinks is not None:
        sink = sinks.astype(jnp.float32).reshape(n_kv, g, 1, 1)
    p = masked_softmax(logits, mask, sink)
    out = jnp.einsum('bnkgql,bnlkd->bnqkgd', p.astype(v.dtype), vp)
    return out.reshape(b, s, h, d)


def nsa_compress(kv, pos_emb, w1, w2):
    b, s, n_kv, d = kv.shape
    n_cmp = (s - CMP_LEN) // CMP_STRIDE + 1
    idx = jnp.arange(n_cmp)[:, None] * CMP_STRIDE + jnp.arange(CMP_LEN)[None, :]
    blocks = kv[:, idx] + pos_emb[None, None, :, None, :]
    blocks = jnp.moveaxis(blocks, 3, 2).reshape(b, n_cmp, n_kv, CMP_LEN * d)
    return jax.nn.gelu(blocks @ w1) @ w2


def selection_weights(n_cmp, n_sel):
    starts = np.arange(n_cmp)[:, None] * CMP_STRIDE
    blk = np.arange(n_sel)[None, :] * SEL_BLOCK
    shared = np.clip(np.minimum(starts + CMP_LEN, blk + SEL_BLOCK) - np.maximum(starts, blk), 0, None)
    return (shared / CMP_STRIDE).astype(np.float32)


def nsa_selected_attention(qg, k_sel, v_sel, sel_idx, bias_tbl):
    b, s, n_kv, g, d = qg.shape
    n_top = sel_idx.shape[-1]
    n_sel = s // SEL_BLOCK
    n_keys = n_top * SEL_BLOCK
    scale = d ** -0.5
    kb = jnp.moveaxis(k_sel.reshape(b, n_sel, SEL_BLOCK, n_kv, d), 3, 1)
    vb = jnp.moveaxis(v_sel.reshape(b, n_sel, SEL_BLOCK, n_kv, d), 3, 1)
    tbl = jnp.moveaxis(bias_tbl.reshape(N_BUCKETS, n_kv, g), 0, 1)
    n_chunk = s // NSA_Q_CHUNK
    q_chunks = jnp.moveaxis(qg.reshape(b, n_chunk, NSA_Q_CHUNK, n_kv, g, d), 1, 0)
    idx_chunks = jnp.moveaxis(sel_idx.reshape(b, n_kv, n_chunk, NSA_Q_CHUNK, n_top), 2, 0)
    starts = jnp.arange(n_chunk) * NSA_Q_CHUNK
    bi = jnp.arange(b)[:, None, None, None]
    kvi = jnp.arange(n_kv)[None, :, None, None]
    pos_in_blk = jnp.arange(SEL_BLOCK)

    def chunk(xs):
        q_c, idx_c, start = xs
        t_c = start + jnp.arange(NSA_Q_CHUNK)
        k_c = kb[bi, kvi, idx_c]
        v_c = vb[bi, kvi, idx_c]
        dist = t_c[:, None, None] - (idx_c[..., None] * SEL_BLOCK + pos_in_blk)
        bias = jnp.moveaxis(tbl[kvi[..., None], t5_bucket(dist)], -1, 2)
        logits = jnp.einsum('bqkgd,bkqnld->bkgqnl', q_c, k_c, preferred_element_type=jnp.float32) * scale + bias
        mask = (dist >= 0)[:, :, None]
        p = masked_softmax(logits.reshape(b, n_kv, g, NSA_Q_CHUNK, n_keys),
                           mask.reshape(b, n_kv, 1, NSA_Q_CHUNK, n_keys))
        return jnp.einsum('bkgqm,bkqmd->bqkgd', p.astype(v_sel.dtype),
                          v_c.reshape(b, n_kv, NSA_Q_CHUNK, n_keys, d))

    out = lax.map(chunk, (q_chunks, idx_chunks, starts))
    return jnp.moveaxis(out, 0, 1).reshape(b, s, n_kv * g, d)


def nsa_attention(q, k_cmp, v_cmp, k_sel, v_sel, k_win, v_win, gate_logits, cmp_pos, cmp_w1, cmp_w2, bias_tbl):
    b, s, h, d = q.shape
    n_kv = k_cmp.shape[2]
    g = h // n_kv
    scale = d ** -0.5
    qg = q.reshape(b, s, n_kv, g, d)
    t = jnp.arange(s)
    kc = nsa_compress(k_cmp, cmp_pos[0], cmp_w1[0], cmp_w2[0])
    vc = nsa_compress(v_cmp, cmp_pos[1], cmp_w1[1], cmp_w2[1])
    n_cmp = kc.shape[1]
    dist_c = t[:, None] - (jnp.arange(n_cmp) * CMP_STRIDE + CMP_LEN - 1)[None, :]
    bias_c = jnp.moveaxis(bias_tbl[t5_bucket(dist_c)], -1, 0).reshape(n_kv, g, s, n_cmp)
    logits_c = jnp.einsum('bskgd,bckd->bkgsc', qg, kc, preferred_element_type=jnp.float32) * scale + bias_c
    p_cmp = masked_softmax(logits_c, dist_c >= 0)
    o_cmp = jnp.einsum('bkgsc,bckd->bskgd', p_cmp.astype(vc.dtype), vc).reshape(b, s, h, d)
    n_sel = s // SEL_BLOCK
    n_top = min(SEL_TOP_N, n_sel)
    share = jnp.asarray(selection_weights(n_cmp, n_sel))
    importance = jnp.einsum('bkgsc,cj->bksj', p_cmp, share)
    blk = jnp.arange(n_sel)[None, :]
    cur = (t // SEL_BLOCK)[:, None]
    forced = (blk == 0) | (blk == cur) | (blk == cur - 1)
    score = jnp.where(forced, FORCE_SCORE, jnp.where(blk <= cur, importance, NEG_INF))
    _, sel_idx = lax.top_k(score, n_top)
    o_sel = nsa_selected_attention(qg, k_sel, v_sel, sel_idx, bias_tbl)
    o_win = banded_attention(q, k_win, v_win, bias_tbl, NSA_WINDOW)
    gate = jax.nn.sigmoid(gate_logits.astype(jnp.float32)).reshape(b, s, h, 3).astype(q.dtype)
    out = gate[..., 0:1] * o_cmp + gate[..., 1:2] * o_sel + gate[..., 2:3] * o_win
    return out.reshape(b, s, h * d)


def moba_attention(q, k, v, bias_tbl):
    b, s, h, d = q.shape
    n_kv = k.shape[2]
    g = h // n_kv
    scale = d ** -0.5
    n_blk = -(-s // MOBA_BLOCK)
    padding = ((0, 0), (0, n_blk * MOBA_BLOCK - s), (0, 0), (0, 0))
    kb = jnp.moveaxis(jnp.pad(k, padding).reshape(b, n_blk, MOBA_BLOCK, n_kv, d), 3, 1)
    vb = jnp.moveaxis(jnp.pad(v, padding).reshape(b, n_blk, MOBA_BLOCK, n_kv, d), 3, 1)
    qg = q.reshape(b, s, n_kv, g, d)
    tbl = jnp.transpose(bias_tbl.reshape(N_BUCKETS, n_kv, g), (1, 2, 0))
    n_top = min(MOBA_TOP_K, n_blk - 1)
    n_chunk = s // MOBA_Q_CHUNK
    q_chunks = jnp.moveaxis(qg.reshape(b, n_chunk, MOBA_Q_CHUNK, n_kv, g, d), 1, 0)
    starts = jnp.arange(n_chunk) * MOBA_Q_CHUNK
    pos_in_blk = jnp.arange(MOBA_BLOCK)
    bi = jnp.arange(b)[:, None, None, None, None]
    kvi = jnp.arange(n_kv)[None, :, None, None, None]
    gi = jnp.arange(g)[None, None, :, None, None]

    def own_block(q_c, start):
        t_c = start + jnp.arange(MOBA_Q_CHUNK)
        blk = start // MOBA_BLOCK
        k_own = lax.dynamic_index_in_dim(kb, blk, axis=2, keepdims=False)
        v_own = lax.dynamic_index_in_dim(vb, blk, axis=2, keepdims=False)
        dist = t_c[:, None] - (blk * MOBA_BLOCK + pos_in_blk)[None, :]
        logits = jnp.einsum('bqkgd,bkld->bkgql', q_c, k_own, preferred_element_type=jnp.float32) * scale
        logits = logits + tbl[:, :, t5_bucket(dist)]
        mask = jnp.broadcast_to(dist >= 0, logits.shape)
        return logits, mask, v_own, t_c

    if n_top > 0:
        t = jnp.arange(s)
        q_blk = t // MOBA_BLOCK
        k_mean = jnp.mean(kb, axis=3)
        gate = jnp.einsum('bskgd,bknd->bkgsn', qg, k_mean, preferred_element_type=jnp.float32)
        gate = jnp.where(jnp.arange(n_blk)[None, :] < q_blk[:, None], gate, NEG_INF)
        _, sel_idx = lax.top_k(gate, n_top)
        valid = sel_idx < q_blk[:, None]
        idx_chunks = jnp.moveaxis(sel_idx.reshape(b, n_kv, g, n_chunk, MOBA_Q_CHUNK, n_top), 3, 0)
        valid_chunks = jnp.moveaxis(valid.reshape(b, n_kv, g, n_chunk, MOBA_Q_CHUNK, n_top), 3, 0)
        n_sel_keys = n_top * MOBA_BLOCK

        def chunk(xs):
            q_c, start, idx_c, valid_c = xs
            logits_own, mask_own, v_own, t_c = own_block(q_c, start)
            k_sel = kb[bi, kvi, idx_c]
            v_sel = vb[bi, kvi, idx_c]
            dist = t_c[:, None, None] - (idx_c[..., None] * MOBA_BLOCK + pos_in_blk)
            bias = tbl[kvi[..., None], gi[..., None], t5_bucket(dist)]
            logits_sel = jnp.einsum('bqkgd,bkgqnld->bkgqnl', q_c, k_sel, preferred_element_type=jnp.float32) * scale + bias
            logits_sel = logits_sel.reshape(b, n_kv, g, MOBA_Q_CHUNK, n_sel_keys)
            mask_sel = jnp.broadcast_to(valid_c[..., None], dist.shape).reshape(logits_sel.shape)
            p = masked_softmax(jnp.concatenate([logits_sel, logits_own], axis=-1),
                               jnp.concatenate([mask_sel, mask_own], axis=-1)).astype(v.dtype)
            o_sel = jnp.einsum('bkgqm,bkgqmd->bqkgd', p[..., :n_sel_keys],
                               v_sel.reshape(b, n_kv, g, MOBA_Q_CHUNK, n_sel_keys, d))
            o_own = jnp.einsum('bkgql,bkld->bqkgd', p[..., n_sel_keys:], v_own)
            return o_sel + o_own

        out = lax.map(chunk, (q_chunks, starts, idx_chunks, valid_chunks))
    else:
        def chunk(xs):
            q_c, start = xs
            logits_own, mask_own, v_own, _ = own_block(q_c, start)
            p = masked_softmax(logits_own, mask_own).astype(v.dtype)
            return jnp.einsum('bkgql,bkld->bqkgd', p, v_own)

        out = lax.map(chunk, (q_chunks, starts))
    return jnp.moveaxis(out, 0, 1).reshape(b, s, h, d)


def setup_inputs(seed: int = 0) -> dict:
    key = jax.random.key(seed)
    ks = jax.random.split(key, 14)

    def nrm(k, shape, scale):
        return jax.random.normal(k, shape, jnp.float32) * scale

    out_scale = (2 * DEPTH) ** -0.5
    return {
        'x': nrm(ks[0], (BATCH, SEQ, D_MODEL), 1.0),
        'w_in': nrm(ks[1], (DEPTH, D_MODEL, D_IN), D_MODEL ** -0.5),
        'cmp_pos': nrm(ks[2], (DEPTH, 2, CMP_LEN, HEAD_DIM), 0.1),
        'cmp_w1': nrm(ks[3], (DEPTH, 2, CMP_LEN * HEAD_DIM, CMP_HIDDEN), (CMP_LEN * HEAD_DIM) ** -0.5),
        'cmp_w2': nrm(ks[4], (DEPTH, 2, CMP_HIDDEN, HEAD_DIM), CMP_HIDDEN ** -0.5),
        'swa_sinks': nrm(ks[5], (DEPTH, SWA_HEADS), 1.0),
        'w_branch': nrm(ks[6], (DEPTH, N_BRANCHES, MIX_WIDTH, D_MODEL), MIX_WIDTH ** -0.5),
        'w_out': nrm(ks[7], (DEPTH, D_MODEL, D_MODEL), D_MODEL ** -0.5 * out_scale),
        'w_mlp_in': nrm(ks[8], (DEPTH, D_MODEL, D_FF), D_MODEL ** -0.5),
        'w_mlp_out': nrm(ks[9], (DEPTH, D_FF, D_MODEL), D_FF ** -0.5 * out_scale),
        'norm_mix': 1.0 + nrm(ks[10], (DEPTH, D_MODEL), 0.02),
        'norm_mlp': 1.0 + nrm(ks[11], (DEPTH, D_MODEL), 0.02),
        'norm_final': 1.0 + nrm(ks[12], (D_MODEL,), 0.02),
        'rel_bias': nrm(ks[13], (N_BUCKETS, TOTAL_HEADS), 0.5),
    }


def reference(x, w_in, cmp_pos, cmp_w1, cmp_w2, swa_sinks, w_branch, w_out, w_mlp_in, w_mlp_out,
              norm_mix, norm_mlp, norm_final, rel_bias):
    b, s, _ = x.shape
    bias_a = rel_bias[:, :NSA_HEADS]
    bias_b = rel_bias[:, NSA_HEADS:NSA_HEADS + SWA_HEADS]
    bias_c = rel_bias[:, NSA_HEADS + SWA_HEADS:]
    for layer in range(DEPTH):
        h = rms_norm(x, norm_mix[layer])
        (a_q, a_kc, a_vc, a_ks, a_vs, a_kw, a_vw, a_gate,
         b_q, b_k, b_v, c_q, c_k, c_v, merge_gate) = jnp.split(h @ w_in[layer], SPLIT_POINTS, axis=-1)
        o_a = nsa_attention(split_heads(a_q, NSA_HEADS),
                            split_heads(a_kc, NSA_KV_HEADS), split_heads(a_vc, NSA_KV_HEADS),
                            split_heads(a_ks, NSA_KV_HEADS), split_heads(a_vs, NSA_KV_HEADS),
                            split_heads(a_kw, NSA_KV_HEADS), split_heads(a_vw, NSA_KV_HEADS),
                            a_gate, cmp_pos[layer], cmp_w1[layer], cmp_w2[layer], bias_a)
        o_b = banded_attention(split_heads(b_q, SWA_HEADS), split_heads(b_k, SWA_KV_HEADS),
                               split_heads(b_v, SWA_KV_HEADS), bias_b, SWA_WINDOW,
                               swa_sinks[layer]).reshape(b, s, MIX_WIDTH)
        o_c = moba_attention(split_heads(c_q, MOBA_HEADS), split_heads(c_k, MOBA_KV_HEADS),
                             split_heads(c_v, MOBA_KV_HEADS), bias_c).reshape(b, s, MIX_WIDTH)
        branches = jnp.stack([o_a, o_b, o_c], axis=2)
        y = jnp.einsum('bsmc,mcd->bsmd', branches, w_branch[layer])
        gate = jax.nn.sigmoid(merge_gate.reshape(b, s, N_BRANCHES, D_MODEL))
        x = x + jnp.sum(gate * y, axis=2) @ w_out[layer]
        h = rms_norm(x, norm_mlp[layer])
        x = x + jnp.square(jax.nn.relu(h @ w_mlp_in[layer])) @ w_mlp_out[layer]
    return rms_norm(x, norm_final)
```

```cpp
#include <hip/hip_runtime.h>
#include <cstdio>
#include <cstdint>
namespace pg8 {
#define PG8_LAS __attribute__((address_space(3)))
typedef unsigned short bf16_t;
typedef short bf16x8 __attribute__((ext_vector_type(8)));
typedef float f32x4 __attribute__((ext_vector_type(4)));
typedef unsigned u32x4 __attribute__((ext_vector_type(4)));
typedef int i32x8 __attribute__((ext_vector_type(8)));
constexpr int BM = 256, BK = 64, HALF = 128, HTB = HALF * BK * 2  , STAGE_BYTES = 8 * HTB, NXCD = 8, WGM = 8;

__host__ __device__ __forceinline__ int lds_byte(int r, int c) { const int st = (r >> 4) * 2 + (c >> 5), rr = r & 15, cc = c & 31, ob = rr * 64 + cc * 2; return st * 1024 + (ob ^ (((ob >> 9) & 1) << 5)); }
__host__ __device__ __forceinline__ void stage_rc(int b, int& R, int& C) { const int st = b / 1024, sb = b % 1024, swz = sb ^ (((sb >> 9) & 1) << 5); R = (st >> 1) * 16 + swz / 64; C = (st & 1) * 32 + (swz % 64) / 2; }
__host__ __device__ __forceinline__ int perm32(int rho) { const int n = rho >> 4, i = rho & 15; return 8 * (i >> 2) + 4 * n + (i & 3); }

struct Unit { int pm, pn, ko; };
struct Gemm { const bf16_t* A; const bf16_t* Bt; int M, N, K, lda, ldb; };

struct StaticOrder {
    int nM, nN, nwg, G, c;
    __host__ __device__ void init(int M, int N, int G_, int c_) { nM = M / BM; nN = N / BM; nwg = nM * nN; G = G_; c = c_; }
    __host__ __device__ bool next(int i, Unit& u) const {
        const long L = (long)i * G + c; if (L >= nwg) return false;
        int wgid = (int)L; { const int q = nwg / NXCD, r = nwg % NXCD, xcd = wgid % NXCD, off = wgid / NXCD; wgid = (xcd < r ? xcd * (q + 1) : r * (q + 1) + (xcd - r) * q) + off; }
        const int nig = WGM * nN, gid = wgid / nig, fm = gid * WGM, gsz = (nM - fm) < WGM ? (nM - fm) : WGM;
        u.pm = fm + ((wgid % nig) % gsz); u.pn = (wgid % nig) / gsz; u.ko = 0; return true;
    }
    __device__ __forceinline__ void a_ready(const Unit&) const {}
    __device__ __forceinline__ void done(const Unit&) const {}
};
typedef __bf16 bf16x2_n __attribute__((ext_vector_type(2)));
typedef float f32x2_n __attribute__((ext_vector_type(2)));
__device__ __forceinline__ unsigned pk_bf16(float lo, float hi) { f32x2_n v = {lo, hi}; bf16x2_n b = __builtin_convertvector(v, bf16x2_n); return __builtin_bit_cast(unsigned, b); }
__device__ __forceinline__ float bf_lo(unsigned w) { return __builtin_bit_cast(float, w << 16); }
__device__ __forceinline__ float bf_hi(unsigned w) { return __builtin_bit_cast(float, w & 0xffff0000u); }
__device__ __forceinline__ float sigmoidf_(float x) { return __builtin_amdgcn_rcpf(1.0f + __builtin_amdgcn_exp2f(-1.4426950408889634f * x)); }
constexpr int TOK = 8192;

struct EpiProj {
    static constexpr int SCALE_W = 0x79797979, SCALE_A = 0x7f7f7f7f;
    __device__ __forceinline__ bool keep_acc(const Unit&) const { return false; }
    __device__ __forceinline__ int nst(const Unit& u) const { return u.pn < 46 ? 16 : 0; }
    static constexpr bool PERM = true, AFTER_DRAIN = false;
    bf16_t* Q;
    bf16_t* KV;
    unsigned char* MG;
    float* AG;
    __device__ __forceinline__ static unsigned q8(float a, float b, float c, float d) {
        unsigned w = __builtin_amdgcn_cvt_pk_u8_f32(__builtin_rintf(255.f * sigmoidf_(a)), 0, 0u); w = __builtin_amdgcn_cvt_pk_u8_f32(__builtin_rintf(255.f * sigmoidf_(b)), 1, w);
        w = __builtin_amdgcn_cvt_pk_u8_f32(__builtin_rintf(255.f * sigmoidf_(c)), 2, w); return __builtin_amdgcn_cvt_pk_u8_f32(__builtin_rintf(255.f * sigmoidf_(d)), 3, w); }
    __device__ __forceinline__ void operator()(const f32x4 (&acc)[2][2][4][2], const Unit& u, int wr, int wc, int fr, int fq) const {
        const int pn = u.pn; const int row0 = u.pm * BM + wr * 64 + fr;
        typedef unsigned u32x2_ __attribute__((ext_vector_type(2)));
        int mode = 0, pitch = 1024; bf16_t* base = Q;
        if (pn < 4) { base = Q + pn * 256; }
        else if (pn < 10) { base = KV + (size_t)(pn - 4) * TOK * 256; pitch = 256; mode = (pn < 6) ? 2 : 0; }
        else if (pn < 14) { base = Q + (size_t)TOK * 1024 + (pn - 10) * 256; }
        else if (pn < 16) { base = KV + (size_t)(6 + pn - 14) * TOK * 256; pitch = 256; }
        else if (pn < 20) { base = Q + (size_t)2 * TOK * 1024 + (pn - 16) * 256; }
        else if (pn < 22) { base = KV + (size_t)(8 + pn - 20) * TOK * 256; pitch = 256; }
        else if (pn < 46) mode = 1;
        else mode = 3;
#pragma unroll
        for (int ai = 0; ai < 2; ++ai)
#pragma unroll
            for (int m = 0; m < 4; ++m) { const int row = row0 + ai * HALF + m * 16;
#pragma unroll
                for (int bj = 0; bj < 2; ++bj) { const int cl = bj * HALF + wc * 32 + 8 * fq; const f32x4 v0 = acc[ai][bj][m][0], v1 = acc[ai][bj][m][1];
                    if (mode == 3) {
                        if (cl < 24) { float* o = AG + (size_t)row * 24 + cl;
                            f32x4 s0 = {sigmoidf_(v0[0]), sigmoidf_(v0[1]), sigmoidf_(v0[2]), sigmoidf_(v0[3])}, s1 = {sigmoidf_(v1[0]), sigmoidf_(v1[1]), sigmoidf_(v1[2]), sigmoidf_(v1[3])};
                            *(f32x4*)o = s0; *(f32x4*)(o + 4) = s1; }
                        continue; }
                    if (mode == 1) { u32x2_ w; w.x = q8(v0[0], v0[1], v0[2], v0[3]); w.y = q8(v1[0], v1[1], v1[2], v1[3]);
                        *(u32x2_*)(MG + (size_t)row * 6144 + (pn - 22) * 256 + cl) = w; continue; }
                    u32x4 w; w.x = pk_bf16(v0[0], v0[1]); w.y = pk_bf16(v0[2], v0[3]); w.z = pk_bf16(v1[0], v1[1]); w.w = pk_bf16(v1[2], v1[3]);
                    bf16_t* dst;
                    if (mode == 2) dst = base + ((size_t)(((row >> 11) * 2 + (cl >> 7)) * 2048 + (row & 2047))) * 128 + (cl & 127);
                    else dst = base + (size_t)row * pitch + cl;
                    *(u32x4*)dst = w; } }
    }
};
struct EpiMG {
    static constexpr int SCALE_W = 0x79797979, SCALE_A = 0x7f7f7f7f;
    __device__ __forceinline__ bool keep_acc(const Unit&) const { return false; }
    static constexpr bool PERM = true, AFTER_DRAIN = false;
    unsigned char* MG;
    __device__ __forceinline__ static unsigned q8(float a, float b, float c, float d) {
        unsigned w = __builtin_amdgcn_cvt_pk_u8_f32(__builtin_rintf(255.f * sigmoidf_(a)), 0, 0u); w = __builtin_amdgcn_cvt_pk_u8_f32(__builtin_rintf(255.f * sigmoidf_(b)), 1, w);
        w = __builtin_amdgcn_cvt_pk_u8_f32(__builtin_rintf(255.f * sigmoidf_(c)), 2, w); return __builtin_amdgcn_cvt_pk_u8_f32(__builtin_rintf(255.f * sigmoidf_(d)), 3, w); }
    __device__ __forceinline__ void operator()(const f32x4 (&acc)[2][2][4][2], const Unit& u, int wr, int wc, int fr, int fq) const {
        const int row0 = u.pm * BM + wr * 64 + fr, col0 = u.pn * BM + wc * 32 + 8 * fq;
        typedef unsigned u32x2_ __attribute__((ext_vector_type(2)));
#pragma unroll
        for (int ai = 0; ai < 2; ++ai)
#pragma unroll
            for (int m = 0; m < 4; ++m) { unsigned char* rp = MG + (size_t)(row0 + ai * HALF + m * 16) * 6144 + col0;
#pragma unroll
                for (int bj = 0; bj < 2; ++bj) { const f32x4 v0 = acc[ai][bj][m][0], v1 = acc[ai][bj][m][1];
                    u32x2_ w; w.x = q8(v0[0], v0[1], v0[2], v0[3]); w.y = q8(v1[0], v1[1], v1[2], v1[3]);
                    *(u32x2_*)(rp + bj * HALF) = w; } }
    }
};
struct EpiBranch {
    static constexpr int SCALE_W = 0x79797979, SCALE_A = 0x7b7b7b7b;
    static constexpr bool PERM = true, AFTER_DRAIN = false;
    const unsigned char* MG; bf16_t* Z;
    __device__ __forceinline__ bool keep_acc(const Unit& u) const { return (u.pn >> 3) < 2; }
    __device__ __forceinline__ int nst(const Unit&) const { return 0; }
    __device__ __forceinline__ void operator()(f32x4 (&acc)[2][2][4][2], const Unit& u, int wr, int wc, int fr, int fq) const {
        const int mm = u.pn >> 3, pn = u.pn & 7, pm = u.pm & 31; const int row0 = pm * BM + wr * 64 + fr;
#pragma unroll
        for (int ai = 0; ai < 2; ++ai)
#pragma unroll
            for (int m = 0; m < 4; ++m) { const int row = row0 + ai * HALF + m * 16;
#pragma unroll
                for (int bj = 0; bj < 2; ++bj) { const int col = pn * BM + bj * HALF + wc * 32 + 8 * fq;
                    typedef unsigned u32x2_ __attribute__((ext_vector_type(2)));
                    const unsigned char* gp = MG + (size_t)row * 6144 + mm * 2048 + col;
                    const u32x2_ ga = *(const u32x2_*)gp; u32x2_ gb = ga; if (mm < 2) gb = *(const u32x2_*)(gp + 2048);
                    float f[8]; const unsigned wa[2] = {ga.x, ga.y}, wb[2] = {gb.x, gb.y};
#pragma unroll
                    for (int e = 0; e < 8; ++e) { const float a0 = (float)((wa[e >> 2] >> (8 * (e & 3))) & 255u), b0 = fmaxf((float)((wb[e >> 2] >> (8 * (e & 3))) & 255u), 1e-20f);
                        if (mm == 0) f[e] = a0 * __builtin_amdgcn_rcpf(b0);
                        else if (mm == 1) f[e] = fmaxf(a0, 1e-20f) * __builtin_amdgcn_rcpf(b0);
                        else f[e] = fmaxf(a0, 1e-20f) * (1.0f / 255.0f); }
                    f32x4 v0 = acc[ai][bj][m][0], v1 = acc[ai][bj][m][1];
                    v0[0] *= f[0]; v0[1] *= f[1]; v0[2] *= f[2]; v0[3] *= f[3]; v1[0] *= f[4]; v1[1] *= f[5]; v1[2] *= f[6]; v1[3] *= f[7];
                    if (mm < 2) { acc[ai][bj][m][0] = v0; acc[ai][bj][m][1] = v1; }
                    else { u32x4 w; w.x = pk_bf16(v0[0], v0[1]); w.y = pk_bf16(v0[2], v0[3]); w.z = pk_bf16(v1[0], v1[1]); w.w = pk_bf16(v1[2], v1[3]);
                        *(u32x4*)(Z + (size_t)row * 2048 + col) = w; } } }
    }
};
struct EpiResid {
    static constexpr int SCALE_W = 0x7f7f7f7f, SCALE_A = 0x7f7f7f7f;
    __device__ __forceinline__ bool keep_acc(const Unit&) const { return false; }
    static constexpr bool PERM = false, AFTER_DRAIN = false;
    const float* Xin; float* Xout;
    __device__ __forceinline__ void operator()(const f32x4 (&acc)[2][2][4][2], const Unit& u, int wr, int wc, int fr, int fq) const {
        const int row0 = u.pm * BM + wr * 64 + fr, col0 = u.pn * BM + wc * 32 + 4 * fq;
#pragma unroll
        for (int ai = 0; ai < 2; ++ai)
#pragma unroll
            for (int m = 0; m < 4; ++m) { const size_t ro = (size_t)(row0 + ai * HALF + m * 16) * 2048;
#pragma unroll
                for (int bj = 0; bj < 2; ++bj)
#pragma unroll
                    for (int n = 0; n < 2; ++n) { const size_t o = ro + col0 + bj * HALF + n * 16;
                        *(f32x4*)(Xout + o) = *(const f32x4*)(Xin + o) + acc[ai][bj][m][n]; } }
    }
};
struct EpiResidN {
    static constexpr int SCALE_W = 0x7f7f7f7f, SCALE_A = 0x7f7f7f7f;
    __device__ __forceinline__ bool keep_acc(const Unit&) const { return false; }
    static constexpr bool PERM = false, AFTER_DRAIN = true;
    const float* Xin; float* Xout; const float* gain; bf16_t* Hp; float* SS;
    __device__ __forceinline__ void operator()(const f32x4 (&)[2][2][4][2], const Unit&, int, int, int, int) const {}
    __device__ __forceinline__ void fused(const f32x4 (&acc)[2][2][4][2], const Unit& u, int wr, int wc, int fr, int fq, PG8_LAS unsigned char* lds, int wid, int lane) const {
        const int row0 = u.pm * BM + wr * 64 + fr, col0 = u.pn * BM + wc * 32 + 4 * fq;
        PG8_LAS float* red = (PG8_LAS float*)lds;
#pragma unroll
        for (int ai = 0; ai < 2; ++ai)
#pragma unroll
            for (int m = 0; m < 4; ++m) { const size_t ro = (size_t)(row0 + ai * HALF + m * 16) * 2048; float ss = 0.f;
#pragma unroll
                for (int bj = 0; bj < 2; ++bj)
#pragma unroll
                    for (int n = 0; n < 2; ++n) { const size_t o = ro + col0 + bj * HALF + n * 16;
                        const f32x4 x = *(const f32x4*)(Xin + o) + acc[ai][bj][m][n]; *(f32x4*)(Xout + o) = x;
                        const f32x4 g = *(const f32x4*)(gain + col0 + bj * HALF + n * 16);
                        ss += (x[0] * x[0] + x[1] * x[1]) + (x[2] * x[2] + x[3] * x[3]);
                        typedef unsigned u32x2_ __attribute__((ext_vector_type(2)));
                        u32x2_ h; h.x = pk_bf16(x[0] * g[0], x[1] * g[1]); h.y = pk_bf16(x[2] * g[2], x[3] * g[3]); *(u32x2_*)(Hp + o) = h; }
                ss += __shfl_xor(ss, 16); ss += __shfl_xor(ss, 32);
                if (fq == 0) red[(ai * HALF + wr * 64 + m * 16 + fr) * 4 + wc] = ss; }
        asm volatile("s_waitcnt lgkmcnt(0)" ::: "memory"); __builtin_amdgcn_s_barrier(); asm volatile("" ::: "memory");
        const int t = wid * 64 + lane;
        if (t < 256) { const f32x4 p = *(const PG8_LAS f32x4*)(red + t * 4); SS[(size_t)(u.pm * BM + t) * 8 + u.pn] = (p[0] + p[1]) + (p[2] + p[3]); }
    }
};
struct EpiResidS {
    static constexpr int SCALE_W = 0x7f7f7f7f, SCALE_A = 0x7f7f7f7f;
    __device__ __forceinline__ bool keep_acc(const Unit&) const { return false; }
    static constexpr bool PERM = false, AFTER_DRAIN = false;
    float* X; const float* SS;
    __device__ __forceinline__ void operator()(const f32x4 (&acc)[2][2][4][2], const Unit& u, int wr, int wc, int fr, int fq) const {
        const int row0 = u.pm * BM + wr * 64 + fr, col0 = u.pn * BM + wc * 32 + 4 * fq;
        float r2[2][4];
#pragma unroll
        for (int ai = 0; ai < 2; ++ai)
#pragma unroll
            for (int m = 0; m < 4; ++m) { const float* sp = SS + (size_t)(row0 + ai * HALF + m * 16) * 8; const f32x4 a = *(const f32x4*)sp, b = *(const f32x4*)(sp + 4);
                const float s = ((a[0] + a[1]) + (a[2] + a[3])) + ((b[0] + b[1]) + (b[2] + b[3])); r2[ai][m] = 1.0f / (s * (1.0f / 2048.0f) + 1e-6f); }
#pragma unroll
        for (int ai = 0; ai < 2; ++ai)
#pragma unroll
            for (int m = 0; m < 4; ++m) { const size_t ro = (size_t)(row0 + ai * HALF + m * 16) * 2048;
#pragma unroll
                for (int bj = 0; bj < 2; ++bj)
#pragma unroll
                    for (int n = 0; n < 2; ++n) { const size_t o = ro + col0 + bj * HALF + n * 16;
                        *(f32x4*)(X + o) = *(const f32x4*)(X + o) + acc[ai][bj][m][n] * r2[ai][m]; } }
    }
};
struct EpiResidSX {
    static constexpr int SCALE_W = 0x7f7f7f7f, SCALE_A = 0x7f7f7f7f;
    __device__ __forceinline__ bool keep_acc(const Unit&) const { return false; }
    static constexpr bool PERM = false, AFTER_DRAIN = true;
    float* X; const float* SS; float* XCH; unsigned* CNT; const float* gain; bf16_t* H; unsigned char* H8; float* OUT; int last;
    __device__ __forceinline__ void operator()(const f32x4 (&)[2][2][4][2], const Unit&, int, int, int, int) const {}
    __device__ __forceinline__ void fused(f32x4 (&acc)[2][2][4][2], const Unit& u, int wr, int wc, int fr, int fq, PG8_LAS unsigned char* lds, int wid, int lane) const {
        typedef __attribute__((address_space(1))) unsigned gu32_;
        typedef unsigned u32x2_ __attribute__((ext_vector_type(2)));
        const int row0 = u.pm * BM + wr * 64 + fr, col0 = u.pn * BM + wc * 32 + 4 * fq;
        PG8_LAS float* red = (PG8_LAS float*)lds;
        PG8_LAS float* rstd = (PG8_LAS float*)(lds + 4096);
#pragma unroll
        for (int ai = 0; ai < 2; ++ai)
#pragma unroll
            for (int m = 0; m < 4; ++m) { const int row = row0 + ai * HALF + m * 16; const float* sp = SS + (size_t)row * 8; const f32x4 a = *(const f32x4*)sp, b = *(const f32x4*)(sp + 4);
                const float s = ((a[0] + a[1]) + (a[2] + a[3])) + ((b[0] + b[1]) + (b[2] + b[3])), r2 = 1.0f / (s * (1.0f / 2048.0f) + 1e-6f); float ss = 0.f;
#pragma unroll
                for (int bj = 0; bj < 2; ++bj)
#pragma unroll
                    for (int n = 0; n < 2; ++n) { const size_t o = (size_t)row * 2048 + col0 + bj * HALF + n * 16;
                        const f32x4 x = *(const f32x4*)(X + o) + acc[ai][bj][m][n] * r2; acc[ai][bj][m][n] = x;
                        if (!last) *(f32x4*)(X + o) = x;
                        ss += (x[0] * x[0] + x[1] * x[1]) + (x[2] * x[2] + x[3] * x[3]); }
                ss += __shfl_xor(ss, 16); ss += __shfl_xor(ss, 32);
                if (fq == 0) red[(ai * HALF + wr * 64 + m * 16 + fr) * 4 + wc] = ss; }
        asm volatile("s_waitcnt lgkmcnt(0)" ::: "memory"); __builtin_amdgcn_s_barrier(); asm volatile("" ::: "memory");
        const int t = wid * 64 + lane;
        if (t < 256) { const f32x4 p = *(const PG8_LAS f32x4*)(red + t * 4); const float v = (p[0] + p[1]) + (p[2] + p[3]);
            __hip_atomic_store((gu32_*)(XCH + (size_t)(u.pm * BM + t) * 8 + u.pn), __builtin_bit_cast(unsigned, v), __ATOMIC_RELAXED, __HIP_MEMORY_SCOPE_AGENT); }
        asm volatile("s_waitcnt vmcnt(0)" ::: "memory"); __builtin_amdgcn_s_barrier(); asm volatile("" ::: "memory");
        if (t == 0) { gu32_* c = (gu32_*)(CNT + 64 * u.pm);
            (void)__hip_atomic_fetch_add(c, 1u, __ATOMIC_RELAXED, __HIP_MEMORY_SCOPE_AGENT);
            unsigned spins = 0; while (__hip_atomic_load(c, __ATOMIC_RELAXED, __HIP_MEMORY_SCOPE_AGENT) < 8u && ++spins < (1u << 22)) __builtin_amdgcn_s_sleep(1);
            __builtin_amdgcn_fence(__ATOMIC_ACQUIRE, "agent"); asm volatile("s_waitcnt vmcnt(0)" ::: "memory"); }
        asm volatile("s_waitcnt lgkmcnt(0)" ::: "memory"); __builtin_amdgcn_s_barrier(); asm volatile("" ::: "memory");
        if (t < 256) { float s = 0.f;
#pragma unroll
            for (int j = 0; j < 8; ++j) s += __builtin_bit_cast(float, __hip_atomic_load((gu32_*)(XCH + (size_t)(u.pm * BM + t) * 8 + j), __ATOMIC_RELAXED, __HIP_MEMORY_SCOPE_AGENT));
            rstd[t] = 1.0f / sqrtf(s * (1.0f / 2048.0f) + 1e-6f); }
        asm volatile("s_waitcnt lgkmcnt(0)" ::: "memory"); __builtin_amdgcn_s_barrier(); asm volatile("" ::: "memory");
#pragma unroll
        for (int ai = 0; ai < 2; ++ai)
#pragma unroll
            for (int m = 0; m < 4; ++m) { const int rl = ai * HALF + wr * 64 + m * 16 + fr; const float r = rstd[rl]; const size_t ro = (size_t)(u.pm * BM + rl) * 2048;
#pragma unroll
                for (int bj = 0; bj < 2; ++bj)
#pragma unroll
                    for (int n = 0; n < 2; ++n) { const int c = col0 + bj * HALF + n * 16; const f32x4 g = *(const f32x4*)(gain + c); const f32x4 x = acc[ai][bj][m][n];
                        const f32x4 y = {x[0] * r * g[0], x[1] * r * g[1], x[2] * r * g[2], x[3] * r * g[3]};
                        if (last) *(f32x4*)(OUT + ro + c) = y;
                        else { int w = __builtin_amdgcn_cvt_pk_fp8_f32(y[0], y[1], 0, false); w = __builtin_amdgcn_cvt_pk_fp8_f32(y[2], y[3], w, true); *(unsigned*)(H8 + ro + c) = (unsigned)w; } } }
    }
};
struct EpiRelu2 {
    static constexpr int SCALE_W = 0x7f7f7f7f, SCALE_A = 0x7f7f7f7f;
    __device__ __forceinline__ bool keep_acc(const Unit&) const { return false; }
    __device__ __forceinline__ int nst(const Unit&) const { return 16; }
    static constexpr bool PERM = true, AFTER_DRAIN = false;
    bf16_t* U;
    __device__ __forceinline__ void operator()(const f32x4 (&acc)[2][2][4][2], const Unit& u, int wr, int wc, int fr, int fq) const {
        const int row0 = u.pm * BM + wr * 64 + fr, col0 = u.pn * BM + wc * 32 + 8 * fq;
#pragma unroll
        for (int ai = 0; ai < 2; ++ai)
#pragma unroll
            for (int m = 0; m < 4; ++m) { bf16_t* rp = U + (size_t)(row0 + ai * HALF + m * 16) * 8192 + col0;
#pragma unroll
                for (int bj = 0; bj < 2; ++bj) { f32x4 v0 = acc[ai][bj][m][0], v1 = acc[ai][bj][m][1];
#pragma unroll
                    for (int e = 0; e < 4; ++e) { const float a = fmaxf(v0[e], 0.f), b = fmaxf(v1[e], 0.f); v0[e] = a * a; v1[e] = b * b; }
                    u32x4 w; w.x = pk_bf16(v0[0], v0[1]); w.y = pk_bf16(v0[2], v0[3]); w.z = pk_bf16(v1[0], v1[1]); w.w = pk_bf16(v1[2], v1[3]);
                    *(u32x4*)(rp + bj * HALF) = w; } }
    }
};
struct EpiPart {
    static constexpr int SCALE_W = 0x7f7f7f7f, SCALE_A = 0x7f7f7f7f;
    __device__ __forceinline__ bool keep_acc(const Unit&) const { return false; }
    static constexpr bool PERM = false, AFTER_DRAIN = false;
    float* PART;
    __device__ __forceinline__ void operator()(const f32x4 (&acc)[2][2][4][2], const Unit& u, int wr, int wc, int fr, int fq) const {
        const int kv = u.pn, kc = u.ko >> 9, row0 = (u.pm & 3) * BM + wr * 64 + fr, col0 = wc * 32 + 4 * fq;
        float* base = PART + (size_t)(kc * 2 + kv) * 1024 * 256;
#pragma unroll
        for (int ai = 0; ai < 2; ++ai)
#pragma unroll
            for (int m = 0; m < 4; ++m) { float* rp = base + (size_t)(row0 + ai * HALF + m * 16) * 256 + col0;
#pragma unroll
                for (int bj = 0; bj < 2; ++bj)
#pragma unroll
                    for (int n = 0; n < 2; ++n) *(f32x4*)(rp + bj * HALF + n * 16) = acc[ai][bj][m][n]; }
    }
};
struct CmpOrder {
    int c;
    __device__ bool next(int i, Unit& u) const { if (i != 0 || c >= 64) return false; const int kv = c >> 5; u.pm = kv * 4 + ((c >> 3) & 3); u.pn = kv; u.ko = (c & 7) * 512; return true; }
    __device__ __forceinline__ void a_ready(const Unit&) const {}
    __device__ __forceinline__ void done(const Unit&) const {}
};
struct BranchOrder {
    StaticOrder S;
    __device__ bool next(int i, Unit& u) const { Unit t; if (!S.next(i / 3, t)) return false; const int mm = i % 3; u.pm = mm * 32 + t.pm; u.pn = mm * 8 + t.pn; u.ko = 0; return true; }
    __device__ __forceinline__ void a_ready(const Unit&) const {}
    __device__ __forceinline__ void done(const Unit&) const {}
};
template <class Epi, class Sched, bool ALIGN_EPI = false, bool SP2 = false, bool F8 = false>
__device__ __forceinline__ void gemm_phase(PG8_LAS unsigned char* lds, const Gemm g, const Sched& S, const Epi& E) {
    int tid_o = threadIdx.x; asm volatile("" : "+v"(tid_o));
    const int tid = tid_o, wid = __builtin_amdgcn_readfirstlane(tid >> 6), lane = tid & 63, wr = wid >> 2, wc = wid & 3, fr = lane & 15, fq = lane >> 4;
    const int K = g.K, nt = K / BK;
    unsigned voffA[2], voffB[2];
#pragma unroll
    for (int i = 0; i < 2; ++i) { int R, C; stage_rc(tid * 16 + i * 8192, R, C); const int Rb = Epi::PERM ? ((R & ~31) + perm32(R & 31)) : R;
        voffA[i] = (unsigned)(R * g.lda + C) * 2u; voffB[i] = (unsigned)(Rb * g.ldb + C) * 2u; }
    const size_t kstep = (size_t)(BK * 2);
    const size_t hstepA = (size_t)HALF * g.lda * 2, hstepB = (size_t)HALF * g.ldb * 2;
    const size_t tstepA = 2 * hstepA, tstepB = 2 * hstepB;
    const unsigned ldsw = (unsigned)wid * 1024u;
    const int aoff = lds_byte(wr * 64 + fr, fq * (F8 ? 16 : 8)), boff = lds_byte(wc * 32 + fr, fq * (F8 ? 16 : 8));
    constexpr int KSTR = F8 ? 16 : 1024;
    const int scale_w_ = Epi::SCALE_W, scale_a_ = Epi::SCALE_A; (void)scale_w_; (void)scale_a_;
#define PG8_SA(b, h) (((b) * 2 + (h)) * HTB)
#define PG8_SB(b, h) ((4 + (b) * 2 + (h)) * HTB)
#define PG8_STAGE(bufoff, gbase, voff) do { _Pragma("unroll") for (int _i = 0; _i < 2; ++_i) \
        __builtin_amdgcn_global_load_lds((const unsigned*)((const char*)(gbase) + (voff)[_i]), (PG8_LAS unsigned*)(lds + (bufoff) + ldsw + _i * 8192), 16, 0, 0); } while (0)
#define PG8_LDA(dst, b, h) do { _Pragma("unroll") for (int m = 0; m < 4; ++m) _Pragma("unroll") for (int k = 0; k < 2; ++k) dst[m][k] = *(const PG8_LAS bf16x8*)(lds + PG8_SA(b, h) + aoff + m * 2048 + k * KSTR); } while (0)
#define PG8_LDB(dst, b, h) do { _Pragma("unroll") for (int n = 0; n < 2; ++n) _Pragma("unroll") for (int k = 0; k < 2; ++k) dst[n][k] = *(const PG8_LAS bf16x8*)(lds + PG8_SB(b, h) + boff + n * 2048 + k * KSTR); } while (0)
#define PG8_MMA(ai, bj, At, Bt) do { __builtin_amdgcn_s_setprio(1); \
        if constexpr (F8) { _Pragma("unroll") for (int m = 0; m < 4; ++m) _Pragma("unroll") for (int n = 0; n < 2; ++n) \
            asm volatile("v_mfma_scale_f32_16x16x128_f8f6f4 %0, %1, %2, %0, %3, %4 op_sel_hi:[0,0,0]" : "+v"(acc[ai][bj][m][n]) \
                : "v"(__builtin_bit_cast(i32x8, __builtin_shufflevector(Bt[n][0], Bt[n][1], 0, 1, 2, 3, 4, 5, 6, 7, 8, 9, 10, 11, 12, 13, 14, 15))), \
                  "v"(__builtin_bit_cast(i32x8, __builtin_shufflevector(At[m][0], At[m][1], 0, 1, 2, 3, 4, 5, 6, 7, 8, 9, 10, 11, 12, 13, 14, 15))), "v"(scale_w_), "v"(scale_a_)); } \
        else { _Pragma("unroll") for (int m = 0; m < 4; ++m) _Pragma("unroll") for (int n = 0; n < 2; ++n) _Pragma("unroll") for (int k = 0; k < 2; ++k) \
            acc[ai][bj][m][n] = __builtin_amdgcn_mfma_f32_16x16x32_bf16(Bt[n][k], At[m][k], acc[ai][bj][m][n], 0, 0, 0); } \
        __builtin_amdgcn_s_setprio(0); } while (0)
#define PG8_WAIT_V(n) asm volatile("s_waitcnt vmcnt(" #n ")" ::: "memory")
#define PG8_WAIT_L(n) asm volatile("s_waitcnt lgkmcnt(" #n ")" ::: "memory")
#define PG8_BAR __builtin_amdgcn_s_barrier()
#define PG8_SCHED __builtin_amdgcn_sched_barrier(0)
    Unit cur, nxt; int ui = 0, fl = 0;
    if (!S.next(0, cur)) return;
    f32x4 acc[2][2][4][2];
#pragma unroll
    for (int a = 0; a < 2; ++a)
#pragma unroll
        for (int b = 0; b < 2; ++b)
#pragma unroll
            for (int m = 0; m < 4; ++m)
#pragma unroll
                for (int n = 0; n < 2; ++n) acc[a][b][m][n] = (f32x4){0.f, 0.f, 0.f, 0.f};
    bf16x8 At[4][2], B0[2][2], B1[2][2];
    const char* cA = (const char*)g.A + (size_t)cur.pm * tstepA + (size_t)cur.ko * 2; const char* cB = (const char*)g.Bt + (size_t)cur.pn * tstepB + (size_t)cur.ko * 2;
    S.a_ready(cur);
    if constexpr (SP2) {
        PG8_STAGE(PG8_SB(0, 0), cB, voffB); PG8_STAGE(PG8_SB(0, 1), cB + hstepB, voffB); PG8_STAGE(PG8_SA(0, 0), cA, voffA); PG8_STAGE(PG8_SA(0, 1), cA + hstepA, voffA);
        if (wr == 1) PG8_BAR;
        PG8_WAIT_V(2); PG8_BAR;
        PG8_STAGE(PG8_SB(1, 0), cB + kstep, voffB); PG8_STAGE(PG8_SA(1, 0), cA + kstep, voffA); PG8_STAGE(PG8_SB(1, 1), cB + hstepB + kstep, voffB);
        PG8_WAIT_V(6); PG8_BAR;
    } else {
        PG8_STAGE(PG8_SB(0, 0), cB, voffB); PG8_STAGE(PG8_SA(0, 0), cA, voffA); PG8_STAGE(PG8_SB(0, 1), cB + hstepB, voffB); PG8_STAGE(PG8_SA(0, 1), cA + hstepA, voffA);
        if (wr == 1) PG8_BAR;
        PG8_WAIT_V(4); PG8_BAR;
        PG8_STAGE(PG8_SB(1, 0), cB + kstep, voffB); PG8_STAGE(PG8_SA(1, 0), cA + kstep, voffA); PG8_STAGE(PG8_SB(1, 1), cB + hstepB + kstep, voffB);
        PG8_WAIT_V(6); PG8_BAR;
    }
    for (;;) {
        const bool has_next = S.next(ui + 1, nxt);
        const char* nA = has_next ? (const char*)g.A + (size_t)nxt.pm * tstepA + (size_t)nxt.ko * 2 : cA; const char* nB = has_next ? (const char*)g.Bt + (size_t)nxt.pn * tstepB + (size_t)nxt.ko * 2 : cB;
#pragma clang loop unroll(disable)
        for (int t = 0; t < nt; t += 2) {
            const bool last = (t == nt - 2);
            int fl_ = fl; asm volatile("" : "+s"(fl_)); fl = 0;
            const bool first = fl_ & 1;
            const bool rlx = fl_ & 2;
            const char* a1 = cA + (size_t)(t + 1) * kstep;
            const char* a2 = last ? nA : cA + (size_t)(t + 2) * kstep; const char* b2 = last ? nB : cB + (size_t)(t + 2) * kstep;
            const char* a3 = a2 + kstep; const char* b3 = b2 + kstep;
            if (last && has_next) S.a_ready(nxt);
            if constexpr (SP2) {
            PG8_LDB(B0, 0, 0); PG8_LDB(B1, 0, 1); PG8_SCHED; PG8_LDA(At, 0, 0); if (!first) PG8_STAGE(PG8_SA(1, 1), a1 + hstepA, voffA);
            if (rlx) PG8_WAIT_V(24); else PG8_WAIT_V(8);
            PG8_WAIT_L(0); PG8_BAR; PG8_MMA(0, 0, At, B0); PG8_MMA(0, 1, At, B1); PG8_BAR; PG8_SCHED;
            PG8_LDA(At, 0, 1); PG8_STAGE(PG8_SB(0, 0), b2, voffB); PG8_STAGE(PG8_SB(0, 1), b2 + hstepB, voffB); PG8_STAGE(PG8_SA(0, 0), a2, voffA);
            if (rlx) PG8_WAIT_V(24); else PG8_WAIT_V(8);
            PG8_WAIT_L(0); PG8_BAR; PG8_MMA(1, 0, At, B0); PG8_MMA(1, 1, At, B1); PG8_BAR; PG8_SCHED;
            PG8_LDB(B0, 1, 0); PG8_LDB(B1, 1, 1); PG8_SCHED; PG8_LDA(At, 1, 0); PG8_STAGE(PG8_SA(0, 1), a2 + hstepA, voffA);
            if (rlx) PG8_WAIT_V(24); else PG8_WAIT_V(8);
            PG8_WAIT_L(0); PG8_BAR; PG8_MMA(0, 0, At, B0); PG8_MMA(0, 1, At, B1); PG8_BAR; PG8_SCHED;
            PG8_LDA(At, 1, 1); PG8_STAGE(PG8_SB(1, 0), b3, voffB); PG8_STAGE(PG8_SB(1, 1), b3 + hstepB, voffB); PG8_STAGE(PG8_SA(1, 0), a3, voffA);
            PG8_WAIT_V(8); PG8_WAIT_L(0); PG8_BAR; PG8_MMA(1, 0, At, B0); PG8_MMA(1, 1, At, B1); PG8_BAR; PG8_SCHED;
            } else {
            PG8_LDB(B0, 0, 0); PG8_SCHED; PG8_LDA(At, 0, 0); PG8_STAGE(PG8_SA(1, 1), a1 + hstepA, voffA);
            PG8_WAIT_L(8); PG8_BAR; PG8_WAIT_L(0); PG8_MMA(0, 0, At, B0); PG8_BAR; PG8_SCHED;
            PG8_LDB(B1, 0, 1); PG8_STAGE(PG8_SB(0, 0), b2, voffB);
            PG8_BAR; PG8_WAIT_L(0); PG8_MMA(0, 1, At, B1); PG8_BAR;
            PG8_LDA(At, 0, 1); PG8_STAGE(PG8_SA(0, 0), a2, voffA);
            PG8_BAR; PG8_WAIT_L(0); PG8_MMA(1, 0, At, B0); PG8_BAR; PG8_SCHED;
            PG8_STAGE(PG8_SB(0, 1), b2 + hstepB, voffB);
            PG8_WAIT_V(6); PG8_BAR; PG8_MMA(1, 1, At, B1); PG8_BAR;
            PG8_LDB(B0, 1, 0); PG8_SCHED; PG8_LDA(At, 1, 0); PG8_STAGE(PG8_SA(0, 1), a2 + hstepA, voffA);
            PG8_WAIT_L(8); PG8_BAR; PG8_WAIT_L(0); PG8_MMA(0, 0, At, B0); PG8_BAR; PG8_SCHED;
            PG8_LDB(B1, 1, 1); PG8_STAGE(PG8_SB(1, 0), b3, voffB);
            PG8_BAR; PG8_WAIT_L(0); PG8_MMA(0, 1, At, B1); PG8_BAR;
            PG8_LDA(At, 1, 1); PG8_STAGE(PG8_SA(1, 0), a3, voffA);
            PG8_BAR; PG8_WAIT_L(0); PG8_MMA(1, 0, At, B0); PG8_BAR; PG8_SCHED;
            PG8_STAGE(PG8_SB(1, 1), b3 + hstepB, voffB);
            PG8_WAIT_V(6); PG8_BAR; PG8_MMA(1, 1, At, B1); PG8_BAR;
            }
        }
        if constexpr (ALIGN_EPI) { if (wr == 0) PG8_BAR; }
        if constexpr (ALIGN_EPI && SP2) { if (has_next) PG8_STAGE(PG8_SA(1, 1), nA + kstep + hstepA, voffA); }
        if constexpr (F8) asm volatile("s_nop 15\n\ts_nop 15\n\ts_nop 15" ::: "memory");
        if constexpr (!Epi::AFTER_DRAIN) { E(acc, cur, wr, wc, fr, fq); S.done(cur); }
        if (!has_next) break;
        if (!E.keep_acc(cur)) {
#pragma unroll
        for (int a = 0; a < 2; ++a)
#pragma unroll
            for (int b = 0; b < 2; ++b)
#pragma unroll
                for (int m = 0; m < 4; ++m)
#pragma unroll
                    for (int n = 0; n < 2; ++n) acc[a][b][m][n] = (f32x4){0.f, 0.f, 0.f, 0.f};
        }
        if constexpr (ALIGN_EPI && SP2) fl = E.nst(cur) >= 16 ? 3 : 1;
        cur = nxt; cA = nA; cB = nB; ++ui;
        if constexpr (ALIGN_EPI) { if (wr == 1) PG8_BAR; }
    }
    PG8_WAIT_V(0);
    if constexpr (!ALIGN_EPI) { if (wr == 0) PG8_BAR; }
    PG8_BAR;
    if constexpr (Epi::AFTER_DRAIN) { E.fused(acc, cur, wr, wc, fr, fq, lds, wid, lane); S.done(cur); }
#undef PG8_SA
#undef PG8_SB
#undef PG8_STAGE
#undef PG8_LDA
#undef PG8_LDB
#undef PG8_MMA
#undef PG8_WAIT_V
#undef PG8_WAIT_L
#undef PG8_BAR
#undef PG8_SCHED
}
}
constexpr int NB = 4, SEQ = 2048, DM = 2048, DEPTH = 4, DFF = 8192, DIN = 11800, DINP = 12032  ;
static_assert(NB * SEQ == pg8::TOK, "tokens");
constexpr int NWAVES = 8;
constexpr size_t MiB = 1u << 20;
constexpr size_t WS_CTL = 0, CTL_ZERO_BYTES = 192 * 1024;
constexpr size_t WS_WIN8 = 2 * MiB;
constexpr size_t WS_H8 = 146 * MiB;
constexpr size_t WS_WBR = 190 * MiB;
constexpr size_t WS_WOUT = 238 * MiB;
constexpr size_t WS_WMI = 270 * MiB;
constexpr size_t WS_WMO = 398 * MiB;
constexpr size_t WS_CW1 = 526 * MiB;
constexpr size_t WS_CW2 = 542 * MiB;
constexpr size_t WS_CBP = 543 * MiB;
constexpr size_t WS_X = 544 * MiB;
constexpr size_t WS_H = 608 * MiB;
constexpr size_t WS_Q = 640 * MiB;
constexpr size_t WS_KV = 688 * MiB;
constexpr size_t WS_MG = 729 * MiB;
constexpr size_t WS_AG = 825 * MiB;
constexpr size_t WS_KC = 826 * MiB;
constexpr size_t WS_O = 827 * MiB;
constexpr size_t WS_O8 = 875 * MiB;
constexpr size_t WS_Z = 939 * MiB;
constexpr size_t WS_U = 971 * MiB;
constexpr size_t WS_PART = 1099 * MiB;
constexpr size_t WS_SS = 1115 * MiB;
constexpr size_t WS_XCH = 1116 * MiB;
constexpr size_t WS_END = 1117 * MiB;
constexpr int CW_BAR = 4096;
constexpr int CW_CNT = 32768;
constexpr int CW_WQ = 16384;
constexpr int RING_OFF = 0, RING_BYTES = 131072;
constexpr int LDSCTL_OFF = RING_BYTES, MISC_OFF = LDSCTL_OFF + 320;
constexpr int LDS_BYTES = 147456;
static_assert(MISC_OFF + 128 <= LDS_BYTES, "LDS map");

#define GAS __attribute__((address_space(1)))
#define LAS __attribute__((address_space(3)))
typedef unsigned short bf16;
typedef unsigned v4u __attribute__((ext_vector_type(4)));
typedef unsigned v2u __attribute__((ext_vector_type(2)));
typedef float f32x4 __attribute__((ext_vector_type(4)));
typedef float f32x16 __attribute__((ext_vector_type(16)));
typedef short bf16x8 __attribute__((ext_vector_type(8)));
typedef short s16x4 __attribute__((ext_vector_type(4)));
typedef GAS unsigned gu32;
#define RLX_AGENT __ATOMIC_RELAXED, __HIP_MEMORY_SCOPE_AGENT
#define LDS_WAIT() asm volatile("s_waitcnt lgkmcnt(0)" ::: "memory")
#define VM_WAIT() asm volatile("s_waitcnt vmcnt(0)" ::: "memory")
using pg8::pk_bf16; using pg8::bf_lo; using pg8::bf_hi;

#define XB_TMO      128
#define XB_XCNT(j)  (256  + 64 * (j))
#define XB_XSUB(j)  (1280 + 64 * (j))
#define XB_XGEN(j)  (2304 + 64 * (j))
#define XB_TOP      3328
#define XB_TOPGEN   3392
#define XCD_BAR_WORDS 3456
#define XB_SPIN_CAP (1u << 18)

__device__ __forceinline__ unsigned xb_ld(unsigned* p)              { return __hip_atomic_load(p, __ATOMIC_RELAXED, __HIP_MEMORY_SCOPE_AGENT); }
__device__ __forceinline__ unsigned xb_add(unsigned* p, unsigned v) { return __hip_atomic_fetch_add(p, v, __ATOMIC_RELAXED, __HIP_MEMORY_SCOPE_AGENT); }
__device__ __forceinline__ unsigned xb_xcc_id() { return (unsigned)__builtin_amdgcn_s_getreg((3 << 11) | 20) & 0xFu; }
#define XB_SPIN(cond, bar) do { unsigned _sp = 0; while (cond) { __builtin_amdgcn_s_sleep(1); \
    if ((++_sp & 255u) == 0u) { if (xb_ld(&(bar)[XB_TMO])) break; if (_sp > XB_SPIN_CAP) { atomicAdd(&(bar)[XB_TMO], 1u); break; } } } } while (0)

struct XcdBarrier {
    unsigned* bar; unsigned x;
    volatile LAS unsigned* st;
};

__device__ __forceinline__ XcdBarrier xcd_barrier_post(unsigned* bar, volatile LAS unsigned* st) {
    XcdBarrier b; b.bar = bar; b.x = xb_xcc_id(); b.st = st;
    if (threadIdx.x == 0) (void)xb_add(&bar[XB_XCNT(b.x)], 1u);
    return b;
}
__device__ __forceinline__ void xcd_barrier_complete(unsigned* bar, unsigned x, unsigned& nloc, unsigned& nx) {
    const unsigned G = gridDim.x * gridDim.y * gridDim.z;
    unsigned sum, cnt, mine, sp = 0u;
    for (;;) {
        sum = 0u; cnt = 0u; mine = 0u;
#pragma unroll
        for (unsigned j = 0; j < 16; ++j) { const unsigned c = xb_ld(&bar[XB_XCNT(j)]); sum += c; cnt += (c > 0u) ? 1u : 0u; mine = (j == x) ? c : mine; }
        if (sum == G) break;
        __builtin_amdgcn_s_sleep(1);
        if ((++sp & 255u) == 0u) { if (xb_ld(&bar[XB_TMO])) break; if (sp > XB_SPIN_CAP) { atomicAdd(&bar[XB_TMO], 1u); break; } }
    }
    nloc = mine > 0u ? mine : 1u; nx = cnt > 0u ? cnt : 1u;
}

__device__ __forceinline__ void xcd_barrier(const XcdBarrier& b) {
    asm volatile("s_waitcnt vmcnt(0)" ::: "memory");
    __syncthreads();
    if (threadIdx.x == 0) {
        unsigned* bar = b.bar;
        __builtin_amdgcn_s_waitcnt(0);
        unsigned nloc = b.st[0], nx = b.st[1];
        if (nloc == 0u) { xcd_barrier_complete(bar, b.x, nloc, nx); b.st[0] = nloc; b.st[1] = nx; }
        const unsigned old = xb_add(&bar[XB_XSUB(b.x)], 1u);
        const unsigned gen = old / nloc;
        if (old + 1u == (gen + 1u) * nloc) {
            __builtin_amdgcn_fence(__ATOMIC_RELEASE, "agent");
            asm volatile("s_waitcnt vmcnt(0)" ::: "memory");
            const unsigned og = xb_add(&bar[XB_TOP], 1u);
            const unsigned tg = og / nx;
            if (og + 1u == (tg + 1u) * nx) xb_add(&bar[XB_TOPGEN], 1u);
            else XB_SPIN(xb_ld(&bar[XB_TOPGEN]) == tg, bar);
            __builtin_amdgcn_fence(__ATOMIC_ACQUIRE, "agent");
            xb_add(&bar[XB_XGEN(b.x)], 1u);
            asm volatile("s_waitcnt vmcnt(0)" ::: "memory");
        } else {
            XB_SPIN(xb_ld(&bar[XB_XGEN(b.x)]) == gen, bar);
            __builtin_amdgcn_fence(__ATOMIC_ACQUIRE, "agent");
            asm volatile("s_waitcnt vmcnt(0)" ::: "memory");
        }
    }
    __syncthreads();
}

__device__ __forceinline__ float wave_sum(float v) {
#pragma unroll
    for (int o = 1; o < 64; o <<= 1) v += __shfl_xor(v, o);
    return v;
}
__device__ __forceinline__ float xhalf_max(float v) { auto rr = __builtin_amdgcn_permlane32_swap(__float_as_uint(v), __float_as_uint(v), false, false); return fmaxf(__uint_as_float(rr[0]), __uint_as_float(rr[1])); }
__device__ __forceinline__ float xhalf_sum(float v) { auto rr = __builtin_amdgcn_permlane32_swap(__float_as_uint(v), __float_as_uint(v), false, false); return __uint_as_float(rr[0]) + __uint_as_float(rr[1]); }

template <int MODE>
__device__ __forceinline__ void p0_transpose_item(const float* W, int K, int N, bf16* WT, LAS float* scr, int item, int lane, const float* pos, float* cbp, unsigned char* W8 = nullptr) {
    const int nblk = (N + 31) / 32, kb = item / nblk, nb = item % nblk, k0 = 64 * kb, n0 = 32 * nb;
    {
        const int c4 = (lane & 7) * 4, nn = n0 + c4; const float* p = W + (size_t)(k0 + (lane >> 3)) * N + nn;
        f32x4 v[8];
#pragma unroll
        for (int i = 0; i < 8; ++i) v[i] = (nn < N) ? *(const f32x4*)(p + (size_t)(8 * i) * N) : (f32x4){0.f, 0.f, 0.f, 0.f};
#pragma unroll
        for (int i = 0; i < 8; ++i) { LAS float* d = scr + (8 * i + (lane >> 3)) * 33 + c4; d[0] = v[i].x; d[1] = v[i].y; d[2] = v[i].z; d[3] = v[i].w; }
    }
    LDS_WAIT(); asm volatile("" ::: "memory");
    if (MODE == 2) {
        const int hf = lane >> 5; float s = 0.f;
#pragma unroll 8
        for (int kk = 0; kk < 32; ++kk) s += pos[k0 + 32 * hf + kk] * scr[(32 * hf + kk) * 33 + (lane & 31)];
        s += __shfl_xor(s, 32);
        if (lane < 32) cbp[(size_t)kb * 256 + n0 + lane] = s;
    }
    const int c = lane & 7;
#pragma unroll
    for (int j = 0; j < 4; ++j) { const int n = (lane >> 3) + 8 * j; const LAS float* s = scr + (8 * c) * 33 + n; const int ng = n0 + n;
        if (MODE == 1 || MODE == 3) {
            if (ng < N) { const int dr8 = (MODE == 3) ? ng : ((ng < 2560) ? ng : ((ng < 2584) ? (11776 + ng - 2560) : (ng - 24)));
                int w0 = __builtin_amdgcn_cvt_pk_fp8_f32(s[0 * 33] * 64.f, s[1 * 33] * 64.f, 0, false); w0 = __builtin_amdgcn_cvt_pk_fp8_f32(s[2 * 33] * 64.f, s[3 * 33] * 64.f, w0, true);
                int w1 = __builtin_amdgcn_cvt_pk_fp8_f32(s[4 * 33] * 64.f, s[5 * 33] * 64.f, 0, false); w1 = __builtin_amdgcn_cvt_pk_fp8_f32(s[6 * 33] * 64.f, s[7 * 33] * 64.f, w1, true);
                *(GAS v2u*)(W8 + (size_t)dr8 * K + k0 + 8 * c) = (v2u){(unsigned)w0, (unsigned)w1}; }
            continue; }
        v4u o; o.x = pk_bf16(s[0 * 33], s[1 * 33]); o.y = pk_bf16(s[2 * 33], s[3 * 33]); o.z = pk_bf16(s[4 * 33], s[5 * 33]); o.w = pk_bf16(s[6 * 33], s[7 * 33]);
        const int dr = ng;
        if (ng < N) *(GAS v4u*)(WT + (size_t)dr * K + k0 + 8 * c) = o; }
    LDS_WAIT(); asm volatile("" ::: "memory");
}
template <bool F32OUT, bool Q8 = false>
__device__ __forceinline__ void rms_row(const float* xrow, const float* gain, bf16* orow, float* frow, int lane, unsigned* q8row = nullptr) {
    const GAS f32x4* xr = (const GAS f32x4*)xrow + lane; const GAS f32x4* gr = (const GAS f32x4*)gain + lane;
    f32x4 v[8]; float s = 0.f;
#pragma unroll
    for (int j = 0; j < 8; ++j) { v[j] = xr[64 * j]; s += (v[j].x * v[j].x + v[j].y * v[j].y) + (v[j].z * v[j].z + v[j].w * v[j].w); }
    const float r = 1.0f / sqrtf(wave_sum(s) * (1.0f / 2048.0f) + 1e-6f);
#pragma unroll
    for (int j = 0; j < 8; ++j) { const f32x4 g = gr[64 * j]; const f32x4 y = {v[j].x * r * g.x, v[j].y * r * g.y, v[j].z * r * g.z, v[j].w * r * g.w};
        if (F32OUT) ((GAS f32x4*)frow)[lane + 64 * j] = y;
        else { if (!Q8) { v2u o; o.x = pk_bf16(y.x, y.y); o.y = pk_bf16(y.z, y.w); ((GAS v2u*)orow)[lane + 64 * j] = o; }
            if (Q8) { int w = __builtin_amdgcn_cvt_pk_fp8_f32(y.x, y.y, 0, false); w = __builtin_amdgcn_cvt_pk_fp8_f32(y.z, y.w, w, true); ((GAS unsigned*)q8row)[lane + 64 * j] = (unsigned)w; } } }
}
namespace att {
constexpr float LOG2E = 1.4426950408889634f;
constexpr float QK_C = 0.08838834764831845f * LOG2E;
constexpr int L_K0 = 0, L_V0 = 16384, L_ST = 32768  , L_IMP = 65536, L_IMPS = 98304, L_B2 = 106752, L_SEL = 108800, L_WM = 109056, L_SLOT = 109088, L_PART = 109120;
constexpr int L_END = L_PART + 2048;
constexpr int L_B2ALL = 131072 + 1024  , L_SINK = L_B2ALL + 12288  ;
static_assert(L_SINK + 128 <= LDS_BYTES && L_B2ALL >= MISC_OFF + 128, "bias tables sit between the LDS control words and the end of the allocation");
static_assert(L_END <= RING_BYTES, "attention LDS map");
struct Soft { float m, l; f32x16 y[4]; };

__device__ __forceinline__ void glds16(const void* g, LAS unsigned char* l) { __builtin_amdgcn_global_load_lds((const unsigned*)g, (LAS unsigned*)l, 16, 0, 0); }
__device__ __forceinline__ void stage_k(LAS unsigned char* dst, const bf16* g, int pitch_el, int wave, int lane) {
#pragma unroll
    for (int i = 0; i < 2; ++i) { const int r0 = 4 * (2 * wave + i), r = r0 + (lane >> 4), p = lane & 15, ch = p ^ (((r & 3) << 2) | ((r >> 2) & 3));
        glds16(g + (size_t)r * pitch_el + ch * 8, dst + r0 * 256); }
}
__device__ __forceinline__ void stage_v(LAS unsigned char* dst, const bf16* g, int pitch_el, int wave, int lane) {
#pragma unroll
    for (int i = 0; i < 2; ++i) { const int I = 2 * wave + i, key = 8 * (I >> 1) + ((lane >> 2) & 7), ch = 4 * (2 * (I & 1) + (lane >> 5)) + (lane & 3);
        glds16(g + (size_t)key * pitch_el + ch * 8, dst + I * 1024); }
}
__device__ __forceinline__ void qk64(f32x16& x0, f32x16& x1, LAS const unsigned char* kb, const bf16x8 (&qf)[8], int lane) {
    const int r = lane & 31, h = lane >> 5; const int xr = ((r & 3) << 2) | ((r >> 2) & 3);
    bf16x8 k0[8], k1[8];
#define QK_LD(ks) do { const int off_ = r * 256 + 16 * ((2 * (ks) + h) ^ xr); k0[ks] = *(LAS const bf16x8*)(kb + off_); k1[ks] = *(LAS const bf16x8*)(kb + off_ + 8192); } while (0)
#define QK_MM(ks) do { x0 = __builtin_amdgcn_mfma_f32_32x32x16_bf16(k0[ks], qf[ks], x0, 0, 0, 0); x1 = __builtin_amdgcn_mfma_f32_32x32x16_bf16(k1[ks], qf[ks], x1, 0, 0, 0); } while (0)
    QK_LD(0); QK_LD(1); QK_LD(2); QK_LD(3); QK_LD(4); QK_LD(5);
    __builtin_amdgcn_sched_barrier(0);
#pragma unroll
    for (int i = 0; i < 16; ++i) { x0[i] = 0.f; x1[i] = 0.f; }
    __builtin_amdgcn_s_setprio(1); QK_MM(0); QK_MM(1); __builtin_amdgcn_s_setprio(0);
    __builtin_amdgcn_sched_barrier(0);
    QK_LD(6); QK_LD(7);
    __builtin_amdgcn_sched_barrier(0);
    __builtin_amdgcn_s_setprio(1); QK_MM(2); QK_MM(3); QK_MM(4); QK_MM(5); QK_MM(6); QK_MM(7); __builtin_amdgcn_s_setprio(0);
#undef QK_LD
#undef QK_MM
}
__device__ __forceinline__ bf16x8 pack8(const f32x16& x, int s) {
    v4u w; w.x = pk_bf16(x[8 * s], x[8 * s + 1]); w.y = pk_bf16(x[8 * s + 2], x[8 * s + 3]); w.z = pk_bf16(x[8 * s + 4], x[8 * s + 5]); w.w = pk_bf16(x[8 * s + 6], x[8 * s + 7]);
    return __builtin_bit_cast(bf16x8, w);
}
__device__ __forceinline__ void pv64p(Soft& S, LAS const unsigned char* vb, const bf16x8 (&pf)[4], int lane) {
    const unsigned va = (unsigned)(uintptr_t)(vb + 8 * ((lane & 3) + 4 * ((lane >> 4) & 1) + 8 * ((lane >> 2) & 3) + 32 * (lane >> 5)));
    s16x4 vlo[16], vhi[16];
#define TRRD(dst, off) asm volatile("ds_read_b64_tr_b16 %0, %1 offset:%2" : "=&v"(dst) : "v"(va), "i"(off) : "memory")
#define PV_LD(q) do { TRRD(vlo[(q) * 4 + 0], ((q) * 8 + 0) * 512); TRRD(vhi[(q) * 4 + 0], ((q) * 8 + 4) * 512); TRRD(vlo[(q) * 4 + 1], ((q) * 8 + 1) * 512); TRRD(vhi[(q) * 4 + 1], ((q) * 8 + 5) * 512); \
                      TRRD(vlo[(q) * 4 + 2], ((q) * 8 + 2) * 512); TRRD(vhi[(q) * 4 + 2], ((q) * 8 + 6) * 512); TRRD(vlo[(q) * 4 + 3], ((q) * 8 + 3) * 512); TRRD(vhi[(q) * 4 + 3], ((q) * 8 + 7) * 512); } while (0)
#define PV_MM(q) do { __builtin_amdgcn_s_setprio(1); _Pragma("unroll") for (int c = 0; c < 4; ++c) { const bf16x8 vf_ = __builtin_shufflevector(vlo[(q) * 4 + c], vhi[(q) * 4 + c], 0, 1, 2, 3, 4, 5, 6, 7); \
        S.y[c] = __builtin_amdgcn_mfma_f32_32x32x16_bf16(vf_, pf[q], S.y[c], 0, 0, 0); } __builtin_amdgcn_s_setprio(0); } while (0)
#define PV_WAIT(n) do { asm volatile("s_waitcnt lgkmcnt(" #n ")" ::: "memory"); __builtin_amdgcn_sched_barrier(0); } while (0)
    __builtin_amdgcn_sched_barrier(0);
    PV_LD(0); PV_LD(1);
    PV_WAIT(8); PV_MM(0); __builtin_amdgcn_sched_barrier(0);
    PV_LD(2);
    PV_WAIT(8); PV_MM(1); __builtin_amdgcn_sched_barrier(0);
    PV_LD(3);
    PV_WAIT(8); PV_MM(2);
    PV_WAIT(0); PV_MM(3);
#undef TRRD
#undef PV_LD
#undef PV_MM
#undef PV_WAIT
}
__device__ __forceinline__ void pv64(Soft& S, LAS const unsigned char* vb, const f32x16& x0, const f32x16& x1, int lane) {
    bf16x8 pf[4];
    pf[0] = pack8(x0, 0); pf[1] = pack8(x0, 1); pf[2] = pack8(x1, 0); pf[3] = pack8(x1, 1);
    pv64p(S, vb, pf, lane);
}
constexpr float THR2 = 8.0f;
__device__ __forceinline__ void score64(Soft& S, bf16x8 (&pf)[4], const bf16x8 (&qf)[8], LAS const unsigned char* kb, int d0, bool rowflag, unsigned wlim, bool general, LAS const float* b2, int lane) {
    f32x16 x0, x1; qk64(x0, x1, kb, qf, lane);
    const int h = lane >> 5; const float NEG = -__builtin_inff(); float tmax = NEG;
    if (general) {
#pragma unroll
        for (int i = 0; i < 16; ++i) { const int d = d0 - ((i & 3) + 8 * (i >> 2) + 4 * h), e = d - 32;
            const float b0 = b2[min(max(d, 0), 127)], b1 = b2[min(max(e, 0), 127)];
            const float v0 = (rowflag && (unsigned)d < wlim) ? fmaf(x0[i], QK_C, b0) : NEG, v1 = (rowflag && (unsigned)e < wlim) ? fmaf(x1[i], QK_C, b1) : NEG;
            x0[i] = v0; x1[i] = v1; tmax = fmaxf(tmax, fmaxf(v0, v1)); }
    } else {
        float mr = fmaxf(x0[0], x1[0]);
#pragma unroll
        for (int i = 1; i < 16; ++i) mr = fmaxf(mr, fmaxf(x0[i], x1[i]));
        tmax = rowflag ? mr * QK_C : NEG;
    }
    tmax = xhalf_max(tmax);
    if (!__all(tmax - S.m <= THR2)) {
        const float mn = fmaxf(S.m, tmax), alpha = __builtin_amdgcn_exp2f(S.m - mn); S.m = mn; S.l *= alpha;
#pragma unroll
        for (int c = 0; c < 4; ++c)
#pragma unroll
            for (int i = 0; i < 16; ++i) S.y[c][i] *= alpha;
    }
    float rs = 0.f;
    if (general) {
        const float mn = S.m;
#pragma unroll
        for (int i = 0; i < 16; ++i) { x0[i] = __builtin_amdgcn_exp2f(x0[i] - mn); x1[i] = __builtin_amdgcn_exp2f(x1[i] - mn); rs += x0[i] + x1[i]; }
    } else {
        const float nm = rowflag ? -S.m : NEG;
#pragma unroll
        for (int i = 0; i < 16; ++i) { x0[i] = __builtin_amdgcn_exp2f(fmaf(x0[i], QK_C, nm)); x1[i] = __builtin_amdgcn_exp2f(fmaf(x1[i], QK_C, nm)); rs += x0[i] + x1[i]; }
    }
    rs = xhalf_sum(rs); S.l += rs;
    pf[0] = pack8(x0, 0); pf[1] = pack8(x0, 1); pf[2] = pack8(x1, 0); pf[3] = pack8(x1, 1);
}
template <int MODE>
__device__ __forceinline__ void run_tiles(Soft& S, const bf16x8 (&qf)[8], LAS unsigned char* lds, unsigned tilemask, unsigned wmask, const bf16* Kg, const bf16* Vg, int pitch_el,
                                          int tq, int wq0, unsigned rowmask, unsigned W, LAS const float* b2, int wave, int lane) {
    tilemask = __builtin_amdgcn_readfirstlane(tilemask); wmask = __builtin_amdgcn_readfirstlane(wmask);
    if (tilemask == 0u) return;
#define RT_STAGE(j, t) do { stage_k(lds + (j) * 32768, Kg + (size_t)(t) * 64 * pitch_el, pitch_el, wave, lane); stage_v(lds + (j) * 32768 + 16384, Vg + (size_t)(t) * 64 * pitch_el, pitch_el, wave, lane); } while (0)
    const bool late = wave >= 4;
    unsigned rem = tilemask; int cur = __builtin_ctz(rem); rem &= rem - 1u; int bi = 0, pbi = -1;
    bf16x8 pf[4];
    RT_STAGE(0, cur);
    for (;;) {
        asm volatile("s_waitcnt vmcnt(0)" ::: "memory");
        asm volatile("s_waitcnt lgkmcnt(0)" ::: "memory"); __builtin_amdgcn_s_barrier(); asm volatile("" ::: "memory");
        int nxt = -1;
        if (rem) { nxt = __builtin_ctz(rem); rem &= rem - 1u; const int bj = bi == 2 ? 0 : bi + 1; RT_STAGE(bj, nxt); }
        if (late && pbi >= 0) { pv64p(S, lds + pbi * 32768 + 16384, pf, lane); pbi = -1; }
        if ((wmask >> cur) & 1u) {
            const int d0 = tq - 64 * cur; bool general = (wq0 - 64 * cur - 63) < 113;
            bool rowflag = true; unsigned wlim = 0x80000000u;
            if (MODE == 0) { wlim = W; general = general || (wq0 + 31 - 64 * cur) >= (int)W; } else if (MODE == 1) rowflag = (rowmask >> cur) & 1u; else rowflag = (rowmask >> (cur >> 2)) & 1u;
            score64(S, pf, qf, lds + bi * 32768, d0, rowflag, wlim, general, b2, lane);
            if (late) pbi = bi; else pv64p(S, lds + bi * 32768 + 16384, pf, lane);
        }
        if (nxt < 0) break;
        cur = nxt; bi = bi == 2 ? 0 : bi + 1;
    }
    if (late && pbi >= 0) pv64p(S, lds + pbi * 32768 + 16384, pf, lane);
    asm volatile("s_waitcnt lgkmcnt(0)" ::: "memory"); __builtin_amdgcn_s_barrier(); asm volatile("" ::: "memory");
#undef RT_STAGE
}
__device__ __forceinline__ int t5_bucket(int n) {
    if (n < 16) return n;
    int b = 16;
    b += (n >= 19) + (n >= 21) + (n >= 24) + (n >= 27) + (n >= 31) + (n >= 35) + (n >= 40) + (n >= 46) + (n >= 52) + (n >= 59) + (n >= 67) + (n >= 77) + (n >= 87) + (n >= 99) + (n >= 113);
    return b;
}
__device__ __forceinline__ void fill_b2all(LAS unsigned char* lds, const float* rel_bias, const float* sinks  , int tid) {
    LAS float* T = (LAS float*)(lds + L_B2ALL);
#pragma unroll
    for (int e = 0; e < 6; ++e) { const int i = tid + 512 * e, col = i >> 7, idx = i & 127; T[i] = (rel_bias[t5_bucket(idx) * 24 + col] - rel_bias[31 * 24 + col]) * LOG2E; }
    if (tid < 8 * DEPTH) ((LAS float*)(lds + L_SINK))[tid] = (sinks[tid] - rel_bias[31 * 24 + 8 + (tid & 7)]) * LOG2E;
}
__device__ __forceinline__ void load_q(bf16x8 (&qf)[8], const bf16* Q, int token, int head, int h) {
#pragma unroll
    for (int ks = 0; ks < 8; ++ks) qf[ks] = *(const bf16x8*)(Q + (size_t)token * 1024 + head * 128 + 16 * ks + 8 * h);
}
__device__ __forceinline__ void soft_init(Soft& S) { S.m = -1e30f; S.l = 0.f;
#pragma unroll
    for (int c = 0; c < 4; ++c)
#pragma unroll
        for (int i = 0; i < 16; ++i) S.y[c][i] = 0.f; }
__device__ __forceinline__ unsigned wave_or32(unsigned v) {
#pragma unroll
    for (int o = 1; o < 32; o <<= 1) v |= (unsigned)__shfl_xor((int)v, o);
    return v;
}
__device__ __forceinline__ unsigned block_or(LAS unsigned char* lds, unsigned wv, int wave, int lane) {
    LAS unsigned* WM = (LAS unsigned*)(lds + L_WM);
    if (lane == 0) WM[wave] = wv;
    __syncthreads();
    unsigned t = 0;
#pragma unroll
    for (int i = 0; i < 8; ++i) t |= WM[i];
    __syncthreads();
    return t;
}
struct Ptrs { const bf16* Q; const bf16* KV; const float* AG; const bf16* KC; const bf16* VC; const bf16* KMEAN; bf16* O; unsigned char* O8; int layer, pad; };

template <bool ADD>
__device__ __forceinline__ void store_o(const Soft& S, float sc, bf16* O, int token, int head, int h) {
    bf16* op = O + (size_t)token * 1024 + head * 128;
#pragma unroll
    for (int c = 0; c < 4; ++c)
#pragma unroll
        for (int ip = 0; ip < 2; ++ip) { v2u pk[2];
#pragma unroll
            for (int e = 0; e < 2; ++e) { const int ii = 2 * ip + e;
                float a0 = S.y[c][4 * ii] * sc, a1 = S.y[c][4 * ii + 1] * sc, a2 = S.y[c][4 * ii + 2] * sc, a3 = S.y[c][4 * ii + 3] * sc;
                if (ADD) { const v2u w = *(const v2u*)(op + 32 * c + 8 * ii + 4 * h); a0 += bf_lo(w.x); a1 += bf_hi(w.x); a2 += bf_lo(w.y); a3 += bf_hi(w.y); }
                pk[e].x = pk_bf16(a0, a1); pk[e].y = pk_bf16(a2, a3); }
            auto rx = __builtin_amdgcn_permlane32_swap(pk[0].x, pk[1].x, false, false); auto ry = __builtin_amdgcn_permlane32_swap(pk[0].y, pk[1].y, false, false);
            const v4u o = {rx[0], ry[0], rx[1], ry[1]};
            *(v4u*)(op + 32 * c + 16 * ip + 8 * h) = o; }
}

template <bool ADD>
__device__ __forceinline__ void store_o8(const Soft& S, float sc, const bf16* O, unsigned char* O8, int token, int head, int h) {
    const bf16* op = O + (size_t)token * 1024 + head * 128; unsigned char* op8 = O8 + (size_t)token * 1024 + head * 128; const float sc16 = sc * 16.0f;
#pragma unroll
    for (int c = 0; c < 4; ++c)
#pragma unroll
        for (int ip = 0; ip < 2; ++ip) { unsigned pk[2];
#pragma unroll
            for (int e = 0; e < 2; ++e) { const int ii = 2 * ip + e;
                float a0 = S.y[c][4 * ii] * sc16, a1 = S.y[c][4 * ii + 1] * sc16, a2 = S.y[c][4 * ii + 2] * sc16, a3 = S.y[c][4 * ii + 3] * sc16;
                if (ADD) { const v2u w = *(const v2u*)(op + 32 * c + 8 * ii + 4 * h); a0 = fmaf(bf_lo(w.x), 16.0f, a0); a1 = fmaf(bf_hi(w.x), 16.0f, a1); a2 = fmaf(bf_lo(w.y), 16.0f, a2); a3 = fmaf(bf_hi(w.y), 16.0f, a3); }
                int w8 = __builtin_amdgcn_cvt_pk_fp8_f32(a0, a1, 0, false); w8 = __builtin_amdgcn_cvt_pk_fp8_f32(a2, a3, w8, true); pk[e] = (unsigned)w8; }
            auto rx = __builtin_amdgcn_permlane32_swap(pk[0], pk[1], false, false);
            const v2u o = {rx[0], rx[1]};
            *(v2u*)(op8 + 32 * c + 16 * ip + 8 * h) = o; }
}

__device__ __forceinline__ void unit_A(LAS unsigned char* lds, const Ptrs& P, int b, int kvh, int qt, int tid, int wave, int lane) {
    const int g = wave >> 1, qh = wave & 1, n = lane & 31, h = lane >> 5;
    const int wq0 = 64 * qt + 32 * qh, tq = wq0 + n, token = b * SEQ + tq, head = kvh * 4 + g;
    bf16x8 qf[8]; load_q(qf, P.Q, token, head, h);
    { const bf16* kc = P.KC + (size_t)(b * 2 + kvh) * 128 * 128; const bf16* vc = P.VC + (size_t)(b * 2 + kvh) * 128 * 128;
      stage_k(lds + L_K0, kc, 128, wave, lane); stage_k(lds + L_K0 + L_ST, kc + 64 * 128, 128, wave, lane);
      stage_v(lds + L_V0, vc, 128, wave, lane); stage_v(lds + L_V0 + L_ST, vc + 64 * 128, 128, wave, lane); }
    const float g0 = P.AG[(size_t)token * 24 + head * 3], g1 = P.AG[(size_t)token * 24 + head * 3 + 1], g2 = P.AG[(size_t)token * 24 + head * 3 + 2];
    VM_WAIT(); __syncthreads();
    LAS const float* b2 = (LAS const float*)(lds + L_B2ALL) + (kvh * 4 + g) * 128;
    Soft S; soft_init(S);
    {
        f32x16 x[4];
        qk64(x[0], x[1], lds + L_K0, qf, lane); qk64(x[2], x[3], lds + L_K0 + L_ST, qf, lane);
        const float NEG = -__builtin_inff(); float tmax = NEG; const int dbase = tq - 31 - 64 * h;
#pragma unroll
        for (int s4 = 0; s4 < 4; ++s4) {
            const int dmin = wq0 - 512 * s4 - 527, dmax = wq0 + 31 - 512 * s4 - 31;
            if (dmax < 0) {
#pragma unroll
                for (int i = 0; i < 16; ++i) x[s4][i] = NEG;
            } else if (dmin >= 113) {
#pragma unroll
                for (int i = 0; i < 16; ++i) { const int c0 = 32 * s4 + (i & 3) + 8 * (i >> 2); float v = x[s4][i] * QK_C; if (c0 + 4 == 127) v = (h == 0) ? v : NEG; x[s4][i] = v; tmax = fmaxf(tmax, v); }
            } else {
#pragma unroll
                for (int i = 0; i < 16; ++i) { const int c0 = 32 * s4 + (i & 3) + 8 * (i >> 2), d = dbase - 16 * c0;
                    const float bb = b2[min(max(d, 0), 127)]; float v = fmaf(x[s4][i], QK_C, bb);
                    bool ok = d >= 0; if (c0 + 4 == 127) ok = ok && (h == 0);
                    v = ok ? v : NEG; x[s4][i] = v; tmax = fmaxf(tmax, v); }
            }
        }
        tmax = xhalf_max(tmax);
        const float ms = (tmax == NEG) ? 0.f : tmax; float rs = 0.f;
#pragma unroll
        for (int s4 = 0; s4 < 4; ++s4)
#pragma unroll
            for (int i = 0; i < 16; ++i) { x[s4][i] = __builtin_amdgcn_exp2f(x[s4][i] - ms); rs += x[s4][i]; }
        rs = xhalf_sum(rs);
        const float inv = rs > 0.f ? 1.0f / rs : 0.f;
#pragma unroll
        for (int s4 = 0; s4 < 4; ++s4)
#pragma unroll
            for (int i = 0; i < 16; ++i) x[s4][i] *= inv;
        LAS float* IMP = (LAS float*)(lds + L_IMP); const int ql = 32 * qh + n; float prev_s3 = 0.f;
#pragma unroll
        for (int s4 = 0; s4 < 4; ++s4)
#pragma unroll
            for (int ii = 0; ii < 4; ++ii) { const float s3 = x[s4][4 * ii + 3], a = 2.f * (x[s4][4 * ii] + x[s4][4 * ii + 1] + x[s4][4 * ii + 2]) + s3;
                const float send = h ? prev_s3 : s3, recv = __shfl_xor(send, 32);
                IMP[(g * 64 + ql) * 32 + 8 * s4 + 2 * ii + h] = a + recv; prev_s3 = s3; }
        bf16x8 pfa[4], pfb[4];
        pfa[0] = pack8(x[0], 0); pfa[1] = pack8(x[0], 1); pfa[2] = pack8(x[1], 0); pfa[3] = pack8(x[1], 1);
        pfb[0] = pack8(x[2], 0); pfb[1] = pack8(x[2], 1); pfb[2] = pack8(x[3], 0); pfb[3] = pack8(x[3], 1);
        __builtin_amdgcn_sched_barrier(0);
        pv64p(S, lds + L_V0, pfa, lane); pv64p(S, lds + L_V0 + L_ST, pfb, lane);
        store_o<false>(S, g0, P.O, token, head, h);
    }
    __syncthreads();
    unsigned selmask;
    {
        LAS const float* IMP = (LAS const float*)(lds + L_IMP); LAS float* IMPS = (LAS float*)(lds + L_IMPS);
#pragma unroll
        for (int e = 0; e < 4; ++e) { const int idx = tid + 512 * e; IMPS[(idx >> 5) * 33 + (idx & 31)] = (IMP[idx] + IMP[2048 + idx]) + (IMP[4096 + idx] + IMP[6144 + idx]); }
        __syncthreads();
        const int q = tid >> 3, sub = tid & 7, cur = qt; const int quota = 16 - (cur >= 2 ? 3 : cur + 1); unsigned bits = 0u;
        {
            float v4[4]; int rk[4] = {0, 0, 0, 0};
#pragma unroll
            for (int jj = 0; jj < 4; ++jj) v4[jj] = IMPS[q * 33 + sub * 4 + jj];
#pragma clang loop unroll_count(4) vectorize(disable)
            for (int j2 = 1; j2 <= cur - 2; ++j2) { const float v2 = IMPS[q * 33 + j2];
#pragma unroll
                for (int jj = 0; jj < 4; ++jj) rk[jj] += (v2 > v4[jj] || (v2 == v4[jj] && j2 < sub * 4 + jj)) ? 1 : 0; }
#pragma unroll
            for (int jj = 0; jj < 4; ++jj) { const int j = sub * 4 + jj;
                if (j <= cur && (j == 0 || j >= cur - 1 || rk[jj] < quota)) bits |= 1u << j; }
        }
        bits |= (unsigned)__shfl_xor((int)bits, 1); bits |= (unsigned)__shfl_xor((int)bits, 2); bits |= (unsigned)__shfl_xor((int)bits, 4);
        LAS unsigned* SEL = (LAS unsigned*)(lds + L_SEL);
        if (sub == 0) SEL[q] = bits;
        __syncthreads();
        selmask = SEL[32 * qh + n];
    }
    const unsigned wm_sel = wave_or32(selmask);
    const unsigned tm_sel = block_or(lds, wm_sel, wave, lane);
    soft_init(S);
    run_tiles<1>(S, qf, lds, tm_sel, wm_sel, P.KV + (size_t)2 * pg8::TOK * 256 + (size_t)b * SEQ * 256 + kvh * 128, P.KV + (size_t)3 * pg8::TOK * 256 + (size_t)b * SEQ * 256 + kvh * 128, 256, tq, wq0, selmask, 0u, b2, wave, lane);
    store_o<true>(S, S.l > 0.f ? g1 / S.l : 0.f, P.O, token, head, h);
    soft_init(S);
    { const int lo = qt >= 8 ? qt - 8 : 0; const unsigned tm = (qt == 31 ? 0xffffffffu : ((2u << qt) - 1u)) & ~((1u << lo) - 1u);
      run_tiles<0>(S, qf, lds, tm, tm, P.KV + (size_t)4 * pg8::TOK * 256 + (size_t)b * SEQ * 256 + kvh * 128, P.KV + (size_t)5 * pg8::TOK * 256 + (size_t)b * SEQ * 256 + kvh * 128, 256, tq, wq0, 0u, 512u, b2, wave, lane); }
    store_o8<true>(S, S.l > 0.f ? g2 / S.l : 0.f, P.O, P.O8, token, head, h);
}
__device__ __forceinline__ void unit_B(LAS unsigned char* lds, const Ptrs& P, int b, int kvh, int qt, int tid, int wave, int lane) {
    const int g = wave >> 1, qh = wave & 1, n = lane & 31, h = lane >> 5;
    const int wq0 = 64 * qt + 32 * qh, tq = wq0 + n, token = b * SEQ + tq, head = kvh * 4 + g;
    bf16x8 qf[8]; load_q(qf, P.Q + (size_t)pg8::TOK * 1024, token, head, h);
    const float sink2 = ((LAS const float*)(lds + L_SINK))[P.layer * 8 + head];
    LAS const float* b2 = (LAS const float*)(lds + L_B2ALL) + (8 + head) * 128;
    Soft S; soft_init(S);
    const int lo = qt >= 2 ? qt - 2 : 0; const unsigned tm = (qt == 31 ? 0xffffffffu : ((2u << qt) - 1u)) & ~((1u << lo) - 1u);
    run_tiles<0>(S, qf, lds, tm, tm, P.KV + (size_t)6 * pg8::TOK * 256 + (size_t)b * SEQ * 256 + kvh * 128, P.KV + (size_t)7 * pg8::TOK * 256 + (size_t)b * SEQ * 256 + kvh * 128, 256, tq, wq0, 0u, 128u, b2, wave, lane);
    const float den = S.l + __builtin_amdgcn_exp2f(sink2 - S.m);
    store_o8<false>(S, 1.0f / fmaxf(den, 1e-30f), nullptr, P.O8 + (size_t)pg8::TOK * 1024, token, head, h);
}
__device__ __forceinline__ void unit_C(LAS unsigned char* lds, const Ptrs& P, int b, int kvh, int qt, int tid, int wave, int lane) {
    const int g = wave >> 1, qh = wave & 1, n = lane & 31, h = lane >> 5;
    const int wq0 = 64 * qt + 32 * qh, tq = wq0 + n, token = b * SEQ + tq, head = kvh * 4 + g;
    bf16x8 qf[8]; load_q(qf, P.Q + (size_t)2 * pg8::TOK * 1024, token, head, h);
    if (tid < 128) { const int r = tid >> 4, ch = tid & 15; const v4u v = *(const v4u*)(P.KMEAN + (size_t)((b * 2 + kvh) * 8 + r) * 128 + ch * 8);
        *(LAS v4u*)(lds + L_K0 + r * 256 + 16 * (ch ^ (((r & 3) << 2) | ((r >> 2) & 3)))) = v; }
    __syncthreads();
    LAS const float* b2 = (LAS const float*)(lds + L_B2ALL) + (16 + head) * 128;
    const int qblk = qt >> 2; unsigned bm = 1u << qblk;
    {
        f32x16 x0, x1; qk64(x0, x1, lds + L_K0, qf, lane);
        float gv[8];
#pragma unroll
        for (int e = 0; e < 4; ++e) { const float own = x0[e], oth = __shfl_xor(own, 32); gv[e] = h ? oth : own; gv[4 + e] = h ? own : oth; }
#pragma unroll
        for (int k = 0; k < 8; ++k) { int rank = 0;
#pragma unroll
            for (int k2 = 0; k2 < 8; ++k2) if (k2 != k) rank += (k2 < qblk && (gv[k2] > gv[k] || (gv[k2] == gv[k] && k2 < k))) ? 1 : 0;
            if (k < qblk && rank < 3) bm |= 1u << k; }
    }
    const unsigned wbm = wave_or32(bm); unsigned wm = 0u;
#pragma unroll
    for (int k = 0; k < 8; ++k) if ((wbm >> k) & 1u) wm |= 0xfu << (4 * k);
    wm &= (qt == 31 ? 0xffffffffu : ((2u << qt) - 1u));
    const unsigned tm = block_or(lds, wm, wave, lane);
    Soft S; soft_init(S);
    run_tiles<2>(S, qf, lds, tm, wm, P.KV + (size_t)8 * pg8::TOK * 256 + (size_t)b * SEQ * 256 + kvh * 128, P.KV + (size_t)9 * pg8::TOK * 256 + (size_t)b * SEQ * 256 + kvh * 128, 256, tq, wq0, bm, 0u, b2, wave, lane);
    store_o8<false>(S, S.l > 0.f ? 1.0f / S.l : 0.f, nullptr, P.O8 + (size_t)2 * pg8::TOK * 1024, token, head, h);
}
template <int TYPES>
__device__ __forceinline__ void attn_phase(LAS unsigned char* lds, const Ptrs& P, unsigned* head_word, int first, int count, int tid, int wave, int lane) {
    for (;;) {
        if (tid == 0) *(LAS int*)(lds + L_SLOT) = (int)__hip_atomic_fetch_add(head_word, 1u, __ATOMIC_RELAXED, __HIP_MEMORY_SCOPE_AGENT);
        __syncthreads();
        const int pop = __builtin_amdgcn_readfirstlane(*(LAS int*)(lds + L_SLOT));
        __syncthreads();
        if (pop >= count) break;
        const int slot = first + pop, typ = slot >> 8, r = slot & 255, qt = 31 - (r >> 3), b = (r & 7) >> 1, kvh = r & 1;
        int tid_u = tid; asm volatile("" : "+v"(tid_u));
        const int lane_u = tid_u & 63, wave_u = __builtin_amdgcn_readfirstlane(tid_u >> 6);
        if ((TYPES & 1) && typ == 0) unit_A(lds, P, b, kvh, qt, tid_u, wave_u, lane_u);
        else if ((TYPES & 2) && typ == 1) unit_C(lds, P, b, kvh, qt, tid_u, wave_u, lane_u);
        else if ((TYPES & 4) && typ == 2) unit_B(lds, P, b, kvh, qt, tid_u, wave_u, lane_u);
        __syncthreads();
    }
}
}

__device__ __forceinline__ float gelu_tanh(float x) { const float u = 0.7978845608028654f * (x + 0.044715f * x * x * x); const float t = 1.0f - 2.0f / (1.0f + __expf(2.0f * u)); return 0.5f * x * (1.0f + t); }
__device__ __forceinline__ void compress2_unit(LAS unsigned char* lds, const float* part, const bf16* W2t, const float* cbp, bf16* outc, int kv, int rg, int tid, int wave, int lane) {
    typedef float f32x4_ __attribute__((ext_vector_type(4)));
    LAS float* cb = (LAS float*)(lds + att::L_IMP);
    LAS bf16* hid = (LAS bf16*)(lds + att::L_IMP + 1024);
    if (tid < 256) cb[tid] = cbp[tid];
    __syncthreads();
    { const int row = tid >> 5, c8 = (tid & 31) * 8; f32x4_ a0 = {0.f, 0.f, 0.f, 0.f}, a1 = {0.f, 0.f, 0.f, 0.f};
#pragma unroll
      for (int kc = 0; kc < 8; ++kc) { const float* p = part + ((size_t)(kc * 2 + kv) * 1024 + rg * 16 + row) * 256 + c8; a0 += *(const f32x4_*)p; a1 += *(const f32x4_*)(p + 4); }
      v4u w; w.x = pk_bf16(gelu_tanh(a0[0] + cb[c8]), gelu_tanh(a0[1] + cb[c8 + 1])); w.y = pk_bf16(gelu_tanh(a0[2] + cb[c8 + 2]), gelu_tanh(a0[3] + cb[c8 + 3]));
      w.z = pk_bf16(gelu_tanh(a1[0] + cb[c8 + 4]), gelu_tanh(a1[1] + cb[c8 + 5])); w.w = pk_bf16(gelu_tanh(a1[2] + cb[c8 + 6]), gelu_tanh(a1[3] + cb[c8 + 7]));
      *(LAS v4u*)(hid + row * 264 + c8) = w; }
    __syncthreads();
    const int fr = lane & 15, fq = lane >> 4;
    f32x4_ acc2 = {0.f, 0.f, 0.f, 0.f};
    const bf16* wp = W2t + (size_t)(16 * wave + fr) * 256 + 8 * fq;
#pragma unroll
    for (int ks = 0; ks < 8; ++ks) { const bf16x8 a = *(LAS const bf16x8*)(hid + fr * 264 + 32 * ks + 8 * fq), bb = *(const bf16x8*)(wp + 32 * ks);
        acc2 = __builtin_amdgcn_mfma_f32_16x16x32_bf16(a, bb, acc2, 0, 0, 0); }
#pragma unroll
    for (int e = 0; e < 4; ++e) { const int r = rg * 16 + 4 * fq + e; const float v = ((r & 127) == 127) ? 0.f : acc2[e];
        outc[(size_t)r * 128 + 16 * wave + fr] = (bf16)(pk_bf16(v, 0.f) & 0xffffu); }
    __syncthreads();
}
__device__ __forceinline__ void kmean_unit(LAS unsigned char* lds, const bf16* CK, bf16* KMEAN, int u, int tid) {
    const int b = u >> 4, kvh = (u >> 3) & 1, blk = u & 7, d = tid & 127, part = tid >> 7;
    const bf16* p = CK + ((size_t)(b * SEQ + blk * 256) * 256) + kvh * 128 + d; float s = 0.f;
    for (int i = part; i < 256; i += 4) s += __builtin_bit_cast(float, (unsigned)p[(size_t)i * 256] << 16);
    LAS float* pp = (LAS float*)(lds + att::L_PART);
    pp[part * 128 + d] = s;
    __syncthreads();
    if (tid < 128) { const float m = ((pp[tid] + pp[128 + tid]) + (pp[256 + tid] + pp[384 + tid])) * (1.0f / 256.0f);
        KMEAN[(size_t)((b * 2 + kvh) * 8 + blk) * 128 + tid] = (bf16)(pk_bf16(m, 0.f) & 0xffffu); }
    __syncthreads();
}

struct Args { const float* in[14]; float* out; unsigned char* ws; int ph_lo, ph_hi, use_bar, pad; };
template <class T> __device__ __forceinline__ T* as_global(T* p) { return (T*)(GAS T*)p; }
constexpr int N_PHASES = 2 + 8 * DEPTH;

__global__ void __launch_bounds__(NWAVES * 64, 2) trunk_fwd(Args args) {
    extern __shared__ __attribute__((aligned(16))) unsigned char lds_raw[];
    LAS unsigned char* lds = (LAS unsigned char*)lds_raw;
    {   const int t0 = threadIdx.x;
        for (int u = t0; u < (LDS_BYTES - LDSCTL_OFF) / 4; u += NWAVES * 64) ((LAS unsigned*)(lds + LDSCTL_OFF))[u] = 0u;
        __syncthreads();
        att::fill_b2all(lds, as_global(args.in[13]), as_global(args.in[5]), t0);
        __syncthreads(); }
    XcdBarrier bar; bar.bar = (unsigned*)(args.ws + WS_CTL) + CW_BAR; bar.x = 0; bar.st = nullptr;
    if (args.use_bar) bar = xcd_barrier_post((unsigned*)(args.ws + WS_CTL) + CW_BAR, (volatile LAS unsigned*)(lds + MISC_OFF) + 8);
    const int lo = args.ph_lo, hi = args.ph_hi;
#ifndef PHMASK
#define PHMASK 0x3ff
#endif
#ifndef REP_PRO
#define REP_PRO 1
#define REP_PROJ 1
#define REP_PREP 1
#define REP_ATTN 1
#define REP_BR 1
#define REP_NORM 1
#define REP_MI 1
#endif
#define IN(k) (lo <= (k) && (k) < hi)
#define SEAM(k) do { if (IN(k) && IN((k) + 1)) xcd_barrier(bar); } while (0)
#define PHASE_LOCALS() int tid = threadIdx.x; asm volatile("" : "+v"(tid)); const int lane = tid & 63, wave = __builtin_amdgcn_readfirstlane(tid >> 6); \
    GAS unsigned char* wsg_ = (GAS unsigned char*)args.ws; asm volatile("" : "+s"(wsg_)); unsigned char* ws = (unsigned char*)wsg_;     \
    const int G = gridDim.x, bx = blockIdx.x, vcu = (G % 8 == 0) ? (bx % 8) * (G / 8) + bx / 8 : bx, gw = vcu * NWAVES + wave, NGW = G * NWAVES; \
    (void)lane; (void)gw; (void)NGW; (void)vcu; (void)bx

    for (int rep = 0; rep < REP_PRO; ++rep) if ((PHMASK & 1) && IN(0)) {
        PHASE_LOCALS();
        const float* x_in = as_global(args.in[0]); const float* w_in = as_global(args.in[1]); const float* cmp_pos = as_global(args.in[2]); const float* cmp_w1 = as_global(args.in[3]); const float* cmp_w2 = as_global(args.in[4]);
        const float* w_branch = as_global(args.in[6]); const float* w_out = as_global(args.in[7]); const float* w_mlp_in = as_global(args.in[8]); const float* w_mlp_out = as_global(args.in[9]); const float* norm_mix = as_global(args.in[10]);
        bf16* Wmi_t = (bf16*)(ws + WS_WMI); bf16* Wmo_t = (bf16*)(ws + WS_WMO);
        bf16* CW1 = (bf16*)(ws + WS_CW1); bf16* CW2 = (bf16*)(ws + WS_CW2); float* CBP = (float*)(ws + WS_CBP);
        LAS float* scr = (LAS float*)(lds + RING_OFF + wave * 16384);
        constexpr int I_IN = 32 * 369, I_BR = 16 * 64, I_OUT = 32 * 64, I_MI = 32 * 256, I_MO = 128 * 64, I_C1 = 64 * 8, I_C2 = 4 * 4;
        constexpr int I_LAYER = I_IN + 3 * I_BR + I_OUT + I_MI + I_MO + 2 * I_C1 + 2 * I_C2;
        for (int it = gw; it < DEPTH * I_LAYER; it += NGW) {
            const int l = it / I_LAYER; int r = it % I_LAYER;
            if (r < I_IN) { p0_transpose_item<1>(w_in + (size_t)l * DM * DIN, DM, DIN, nullptr, scr, r, lane, nullptr, nullptr, ws + WS_WIN8 + (size_t)l * DINP * DM); continue; } r -= I_IN;
            if (r < 3 * I_BR) { const int m = r / I_BR; p0_transpose_item<3>(w_branch + (size_t)(l * 3 + m) * 1024 * 2048, 1024, 2048, nullptr, scr, r % I_BR, lane, nullptr, nullptr, ws + WS_WBR + (size_t)(l * 3 + m) * 2048 * 1024); continue; } r -= 3 * I_BR;
            if (r < I_OUT) { p0_transpose_item<0>(w_out + (size_t)l * 2048 * 2048, 2048, 2048, (bf16*)(ws + WS_WOUT) + (size_t)l * 2048 * 2048, scr, r, lane, nullptr, nullptr); continue; } r -= I_OUT;
            if (r < I_MI) { p0_transpose_item<0>(w_mlp_in + (size_t)l * 2048 * 8192, 2048, 8192, Wmi_t + (size_t)l * 8192 * 2048, scr, r, lane, nullptr, nullptr); continue; } r -= I_MI;
            if (r < I_MO) { p0_transpose_item<0>(w_mlp_out + (size_t)l * 8192 * 2048, 8192, 2048, Wmo_t + (size_t)l * 2048 * 8192, scr, r, lane, nullptr, nullptr); continue; } r -= I_MO;
            if (r < 2 * I_C1) { const int kv = r / I_C1; p0_transpose_item<2>(cmp_w1 + (size_t)(l * 2 + kv) * 4096 * 256, 4096, 256, CW1 + (size_t)(l * 2 + kv) * 256 * 4096, scr, r % I_C1, lane, cmp_pos + (size_t)(l * 2 + kv) * 4096, CBP + (size_t)(l * 2 + kv) * 64 * 256); continue; } r -= 2 * I_C1;
            { const int kv = r / I_C2; p0_transpose_item<0>(cmp_w2 + (size_t)(l * 2 + kv) * 256 * 128, 256, 128, CW2 + (size_t)(l * 2 + kv) * 128 * 256, scr, r % I_C2, lane, nullptr, nullptr); }
        }
        for (int rr = gw; rr < DEPTH * 232; rr += NGW) { const int l = rr / 232, row = 11800 + rr % 232; GAS v4u* o = (GAS v4u*)(ws + WS_WIN8 + ((size_t)l * DINP + row) * DM);
#pragma unroll
            for (int j = 0; j < 2; ++j) o[lane + 64 * j] = (v4u){0u, 0u, 0u, 0u}; }
        for (int m = gw; m < pg8::TOK; m += NGW) rms_row<false, true>(x_in + (size_t)m * DM, norm_mix, nullptr, nullptr, lane, (unsigned*)(ws + WS_H8 + (size_t)m * DM));
    }
    SEAM(0);

    for (int l = 0; l < DEPTH; ++l) {
        const int pb = 1 + 8 * l;
        for (int rep = 0; rep < REP_PROJ; ++rep) if ((PHMASK & 2) && IN(pb + 0)) {
            PHASE_LOCALS();
            pg8::Gemm g{(const bf16*)(ws + WS_H8), (const bf16*)(ws + WS_WIN8 + (size_t)l * DINP * DM), pg8::TOK, DINP, DM / 2, DM / 2, DM / 2}; pg8::StaticOrder S; S.init(pg8::TOK, DINP, G, bx);
            pg8::EpiProj E{(bf16*)(ws + WS_Q), (bf16*)(ws + WS_KV), ws + WS_MG, (float*)(ws + WS_AG)};
            pg8::gemm_phase<pg8::EpiProj, pg8::StaticOrder, true, true, true>(lds + RING_OFF, g, S, E);
            if (bx == G - 1) {
                const float* cp = (const float*)(ws + WS_CBP) + (size_t)l * 2 * 64 * 256; float* cs = (float*)(ws + WS_CBP + 524288) + (size_t)l * 2 * 256;
                const int kv = tid >> 8, col = tid & 255; float sum = 0.f;
                for (int kb = 0; kb < 64; ++kb) sum += cp[(size_t)(kv * 64 + kb) * 256 + col];
                cs[kv * 256 + col] = sum; }
        }
        SEAM(pb + 0);
        for (int rep = 0; rep < REP_PREP; ++rep) if ((PHMASK & 4) && IN(pb + 1)) {
            PHASE_LOCALS();
            if (bx < 64) {
                pg8::Gemm g{(const bf16*)(ws + WS_KV), (const bf16*)(ws + WS_CW1) + (size_t)l * 2 * 256 * 4096, 2048, 512, 512, 2048, 4096}; pg8::CmpOrder S{bx};
                pg8::EpiPart E{(float*)(ws + WS_PART)};
                pg8::gemm_phase<pg8::EpiPart, pg8::CmpOrder, false, true>(lds + RING_OFF, g, S, E);
            } else {
                if (bx < 128) kmean_unit(lds, (const bf16*)(ws + WS_KV) + (size_t)8 * pg8::TOK * 256, (bf16*)(ws + WS_KC + 524288), bx - 64, tid);
                att::Ptrs P{(const bf16*)(ws + WS_Q), (const bf16*)(ws + WS_KV), (const float*)(ws + WS_AG), (const bf16*)(ws + WS_KC), (const bf16*)(ws + WS_KC + 262144), (const bf16*)(ws + WS_KC + 524288),
                            (bf16*)(ws + WS_O), ws + WS_O8, l, 0};
                att::attn_phase<4>(lds, P, (unsigned*)(ws + WS_CTL) + CW_WQ + 64 * (l + 16 + 4 * rep), 512, 256, tid, wave, lane); }
        }
        SEAM(pb + 1);
        for (int rep = 0; rep < REP_PREP; ++rep) if ((PHMASK & 4) && IN(pb + 2)) {
            PHASE_LOCALS();
            for (int u = vcu; u < 128; u += G) { const int kv = u >> 6, rg = u & 63;
                compress2_unit(lds, (const float*)(ws + WS_PART), (const bf16*)(ws + WS_CW2) + (size_t)(l * 2 + kv) * 128 * 256, (const float*)(ws + WS_CBP + 524288) + (size_t)(l * 2 + kv) * 256,
                               (bf16*)(ws + WS_KC + (kv ? 262144 : 0)), kv, rg, tid, wave, lane); }
        }
        SEAM(pb + 2);
        for (int rep = 0; rep < REP_ATTN; ++rep) if ((PHMASK & 8) && IN(pb + 3)) {
            PHASE_LOCALS();
            att::Ptrs P{(const bf16*)(ws + WS_Q), (const bf16*)(ws + WS_KV), (const float*)(ws + WS_AG), (const bf16*)(ws + WS_KC), (const bf16*)(ws + WS_KC + 262144), (const bf16*)(ws + WS_KC + 524288),
                        (bf16*)(ws + WS_O), ws + WS_O8, l, 0};
            att::attn_phase<3>(lds, P, (unsigned*)(ws + WS_CTL) + CW_WQ + 64 * (l + 4 * rep), 0, 512, tid, wave, lane);
        }
        SEAM(pb + 3);
        for (int rep = 0; rep < REP_BR; ++rep) if ((PHMASK & 16) && IN(pb + 4)) {
            PHASE_LOCALS();
            pg8::Gemm g{(const bf16*)(ws + WS_O8), (const bf16*)(ws + WS_WBR + (size_t)l * 3 * 2048 * 1024), 3 * pg8::TOK, 3 * 2048, 512, 512, 512}; pg8::BranchOrder S; S.S.init(pg8::TOK, 2048, G, bx);
            pg8::EpiBranch E{(const unsigned char*)(ws + WS_MG), (bf16*)(ws + WS_Z)};
            pg8::gemm_phase<pg8::EpiBranch, pg8::BranchOrder, true, true, true>(lds + RING_OFF, g, S, E);
        }
        SEAM(pb + 4);
        if ((PHMASK & 32) && IN(pb + 5)) {
            PHASE_LOCALS();
            pg8::Gemm g{(const bf16*)(ws + WS_Z), (const bf16*)(ws + WS_WOUT) + (size_t)l * 2048 * 2048, pg8::TOK, 2048, 2048, 2048, 2048}; pg8::StaticOrder S; S.init(pg8::TOK, 2048, G, bx);
            pg8::EpiResidN E{(l == 0) ? as_global(args.in[0]) : (const float*)(ws + WS_X), (float*)(ws + WS_X), as_global(args.in[11]) + l * DM, (bf16*)(ws + WS_H), (float*)(ws + WS_SS)};
            pg8::gemm_phase<pg8::EpiResidN, pg8::StaticOrder, false, true>(lds + RING_OFF, g, S, E);
        }
        SEAM(pb + 5);
        for (int rep = 0; rep < REP_MI; ++rep) if ((PHMASK & 128) && IN(pb + 6)) {
            PHASE_LOCALS();
            pg8::Gemm g{(const bf16*)(ws + WS_H), (const bf16*)(ws + WS_WMI) + (size_t)l * 8192 * 2048, pg8::TOK, 8192, 2048, 2048, 2048}; pg8::StaticOrder S; S.init(pg8::TOK, 8192, G, bx);
            pg8::EpiRelu2 E{(bf16*)(ws + WS_U)};
            pg8::gemm_phase<pg8::EpiRelu2, pg8::StaticOrder, true, true>(lds + RING_OFF, g, S, E);
        }
        SEAM(pb + 6);
        if ((PHMASK & 256) && IN(pb + 7)) {
            PHASE_LOCALS();
            pg8::Gemm g{(const bf16*)(ws + WS_U), (const bf16*)(ws + WS_WMO) + (size_t)l * 2048 * 8192, pg8::TOK, 2048, 8192, 8192, 8192}; pg8::StaticOrder S; S.init(pg8::TOK, 2048, G, bx);
            const int last = (l + 1 == DEPTH);
            pg8::EpiResidSX E{(float*)(ws + WS_X), (const float*)(ws + WS_SS), (float*)(ws + WS_XCH), (unsigned*)(ws + WS_CTL) + CW_CNT + 64 * 32 * l, last ? as_global(args.in[12]) : as_global(args.in[10]) + (l + 1) * DM,
                              (bf16*)(ws + WS_H), ws + WS_H8, as_global(args.out), last};
            pg8::gemm_phase<pg8::EpiResidSX, pg8::StaticOrder, false, true>(lds + RING_OFF, g, S, E);
        }
        if (l + 1 < DEPTH) SEAM(pb + 7);
    }
#undef IN
#undef SEAM
}

#ifndef MK_PER_PHASE
#define MK_PER_PHASE 0
#endif
extern "C" void kernel_launch(void* const* d_in, const int* in_sizes, int n_in, void* d_out, int out_size, void* d_ws, size_t ws_size, hipStream_t stream) {
    static int grid = 0;
    if (grid == 0) {
        if (n_in != 14 || out_size != pg8::TOK * DM || ws_size < WS_END) { fprintf(stderr, "kernel_launch: unexpected shapes (n_in %d, out %d, ws %zu < %zu); nothing launched\n", n_in, out_size, ws_size, (size_t)WS_END); grid = -1; return; }
        int dev = 0, cus = 0, per_cu = 0;
        if (hipGetDevice(&dev) != hipSuccess || hipDeviceGetAttribute(&cus, hipDeviceAttributeMultiprocessorCount, dev) != hipSuccess) { grid = -1; return; }
        if (hipFuncSetAttribute((const void*)trunk_fwd, hipFuncAttributeMaxDynamicSharedMemorySize, LDS_BYTES) != hipSuccess) { fprintf(stderr, "kernel_launch: hipFuncSetAttribute failed\n"); grid = -1; return; }
        if (hipOccupancyMaxActiveBlocksPerMultiprocessor(&per_cu, (const void*)trunk_fwd, NWAVES * 64, LDS_BYTES) != hipSuccess || per_cu < 1)
            fprintf(stderr, "kernel_launch: note: occupancy query reports %d workgroups per CU\n", per_cu);
        (void)hipGetLastError();
        grid = cus;
    }
    if (grid < 0) return;
    if (hipMemsetAsync((char*)d_ws + WS_CTL, 0, CTL_ZERO_BYTES, stream) != hipSuccess) { fprintf(stderr, "kernel_launch: memset failed\n"); return; }
    Args a{};
    for (int i = 0; i < 14; ++i) a.in[i] = (const float*)d_in[i];
    a.out = (float*)d_out; a.ws = (unsigned char*)d_ws; a.pad = 0;
#if MK_PER_PHASE
    for (int p = 0; p < N_PHASES - 1; ++p) { a.ph_lo = p; a.ph_hi = p + 1; a.use_bar = 0; hipLaunchKernelGGL(trunk_fwd, dim3(grid), dim3(NWAVES * 64), LDS_BYTES, stream, a); }
#else
    a.ph_lo = 0; a.ph_hi = N_PHASES; a.use_bar = 1;
    hipLaunchKernelGGL(trunk_fwd, dim3(grid), dim3(NWAVES * 64), LDS_BYTES, stream, a);
#endif
    const hipError_t le = hipPeekAtLastError();
    if (le != hipSuccess) fprintf(stderr, "kernel_launch: launch failed: %s\n", hipGetErrorName(le));
}
```

```cpp
#include <hip/hip_runtime.h>
#include <cstdio>
#include <cstdint>
namespace pg8 {
#define PG8_LAS __attribute__((address_space(3)))
typedef unsigned short bf16_t;
typedef short bf16x8 __attribute__((ext_vector_type(8)));
typedef float f32x4 __attribute__((ext_vector_type(4)));
typedef unsigned u32x4 __attribute__((ext_vector_type(4)));
typedef int i32x8 __attribute__((ext_vector_type(8)));
constexpr int BM = 256, BK = 64, HALF = 128, HTB = HALF * BK * 2  , STAGE_BYTES = 8 * HTB, NXCD = 8, WGM = 8;

__host__ __device__ __forceinline__ int lds_byte(int r, int c) { const int st = (r >> 4) * 2 + (c >> 5), rr = r & 15, cc = c & 31, ob = rr * 64 + cc * 2; return st * 1024 + (ob ^ (((ob >> 9) & 1) << 5)); }
__host__ __device__ __forceinline__ void stage_rc(int b, int& R, int& C) { const int st = b / 1024, sb = b % 1024, swz = sb ^ (((sb >> 9) & 1) << 5); R = (st >> 1) * 16 + swz / 64; C = (st & 1) * 32 + (swz % 64) / 2; }
__host__ __device__ __forceinline__ int perm32(int rho) { const int n = rho >> 4, i = rho & 15; return 8 * (i >> 2) + 4 * n + (i & 3); }

struct Unit { int pm, pn, ko; };
struct Gemm { const bf16_t* A; const bf16_t* Bt; int M, N, K, lda, ldb; };

struct StaticOrder {
    int nM, nN, nwg, G, c;
    __host__ __device__ void init(int M, int N, int G_, int c_) { nM = M / BM; nN = N / BM; nwg = nM * nN; G = G_; c = c_; }
    __host__ __device__ bool next(int i, Unit& u) const {
        const long L = (long)i * G + c; if (L >= nwg) return false;
        int wgid = (int)L; { const int q = nwg / NXCD, r = nwg % NXCD, xcd = wgid % NXCD, off = wgid / NXCD; wgid = (xcd < r ? xcd * (q + 1) : r * (q + 1) + (xcd - r) * q) + off; }
        const int nig = WGM * nN, gid = wgid / nig, fm = gid * WGM, gsz = (nM - fm) < WGM ? (nM - fm) : WGM;
        u.pm = fm + ((wgid % nig) % gsz); u.pn = (wgid % nig) / gsz; u.ko = 0; return true;
    }
    __device__ __forceinline__ void a_ready(const Unit&) const {}
    __device__ __forceinline__ void done(const Unit&) const {}
};
typedef __bf16 bf16x2_n __attribute__((ext_vector_type(2)));
typedef float f32x2_n __attribute__((ext_vector_type(2)));
__device__ __forceinline__ unsigned pk_bf16(float lo, float hi) { f32x2_n v = {lo, hi}; bf16x2_n b = __builtin_convertvector(v, bf16x2_n); return __builtin_bit_cast(unsigned, b); }
__device__ __forceinline__ float bf_lo(unsigned w) { return __builtin_bit_cast(float, w << 16); }
__device__ __forceinline__ float bf_hi(unsigned w) { return __builtin_bit_cast(float, w & 0xffff0000u); }
__device__ __forceinline__ float sigmoidf_(float x) { return __builtin_amdgcn_rcpf(1.0f + __builtin_amdgcn_exp2f(-1.4426950408889634f * x)); }
constexpr int TOK = 8192;

struct EpiProj {
    static constexpr int SCALE_W = 0x79797979, SCALE_A = 0x7f7f7f7f;
    __device__ __forceinline__ bool keep_acc(const Unit&) const { return false; }
    __device__ __forceinline__ int nst(const Unit& u) const { return u.pn < 46 ? 16 : 0; }
    static constexpr bool PERM = true, AFTER_DRAIN = false;
    bf16_t* Q;
    bf16_t* KV;
    unsigned char* MG;
    float* AG;
    __device__ __forceinline__ static unsigned q8(float a, float b, float c, float d) {
        unsigned w = __builtin_amdgcn_cvt_pk_u8_f32(__builtin_rintf(255.f * sigmoidf_(a)), 0, 0u); w = __builtin_amdgcn_cvt_pk_u8_f32(__builtin_rintf(255.f * sigmoidf_(b)), 1, w);
        w = __builtin_amdgcn_cvt_pk_u8_f32(__builtin_rintf(255.f * sigmoidf_(c)), 2, w); return __builtin_amdgcn_cvt_pk_u8_f32(__builtin_rintf(255.f * sigmoidf_(d)), 3, w); }
    __device__ __forceinline__ void operator()(const f32x4 (&acc)[2][2][4][2], const Unit& u, int wr, int wc, int fr, int fq) const {
        const int pn = u.pn; const int row0 = u.pm * BM + wr * 64 + fr;
        typedef unsigned u32x2_ __attribute__((ext_vector_type(2)));
        int mode = 0, pitch = 1024; bf16_t* base = Q;
        if (pn < 4) { base = Q + pn * 256; }
        else if (pn < 10) { base = KV + (size_t)(pn - 4) * TOK * 256; pitch = 256; mode = (pn < 6) ? 2 : 0; }
        else if (pn < 14) { base = Q + (size_t)TOK * 1024 + (pn - 10) * 256; }
        else if (pn < 16) { base = KV + (size_t)(6 + pn - 14) * TOK * 256; pitch = 256; }
        else if (pn < 20) { base = Q + (size_t)2 * TOK * 1024 + (pn - 16) * 256; }
        else if (pn < 22) { base = KV + (size_t)(8 + pn - 20) * TOK * 256; pitch = 256; }
        else if (pn < 46) mode = 1;
        else mode = 3;
#pragma unroll
        for (int ai = 0; ai < 2; ++ai)
#pragma unroll
            for (int m = 0; m < 4; ++m) { const int row = row0 + ai * HALF + m * 16;
#pragma unroll
                for (int bj = 0; bj < 2; ++bj) { const int cl = bj * HALF + wc * 32 + 8 * fq; const f32x4 v0 = acc[ai][bj][m][0], v1 = acc[ai][bj][m][1];
                    if (mode == 3) {
                        if (cl < 24) { float* o = AG + (size_t)row * 24 + cl;
                            f32x4 s0 = {sigmoidf_(v0[0]), sigmoidf_(v0[1]), sigmoidf_(v0[2]), sigmoidf_(v0[3])}, s1 = {sigmoidf_(v1[0]), sigmoidf_(v1[1]), sigmoidf_(v1[2]), sigmoidf_(v1[3])};
                            *(f32x4*)o = s0; *(f32x4*)(o + 4) = s1; }
                        continue; }
                    if (mode == 1) { u32x2_ w; w.x = q8(v0[0], v0[1], v0[2], v0[3]); w.y = q8(v1[0], v1[1], v1[2], v1[3]);
                        *(u32x2_*)(MG + (size_t)row * 6144 + (pn - 22) * 256 + cl) = w; continue; }
                    u32x4 w; w.x = pk_bf16(v0[0], v0[1]); w.y = pk_bf16(v0[2], v0[3]); w.z = pk_bf16(v1[0], v1[1]); w.w = pk_bf16(v1[2], v1[3]);
                    bf16_t* dst;
                    if (mode == 2) dst = base + ((size_t)(((row >> 11) * 2 + (cl >> 7)) * 2048 + (row & 2047))) * 128 + (cl & 127);
                    else dst = base + (size_t)row * pitch + cl;
                    *(u32x4*)dst = w; } }
    }
};
struct EpiMG {
    static constexpr int SCALE_W = 0x79797979, SCALE_A = 0x7f7f7f7f;
    __device__ __forceinline__ bool keep_acc(const Unit&) const { return false; }
    static constexpr bool PERM = true, AFTER_DRAIN = false;
    unsigned char* MG;
    __device__ __forceinline__ static unsigned q8(float a, float b, float c, float d) {
        unsigned w = __builtin_amdgcn_cvt_pk_u8_f32(__builtin_rintf(255.f * sigmoidf_(a)), 0, 0u); w = __builtin_amdgcn_cvt_pk_u8_f32(__builtin_rintf(255.f * sigmoidf_(b)), 1, w);
        w = __builtin_amdgcn_cvt_pk_u8_f32(__builtin_rintf(255.f * sigmoidf_(c)), 2, w); return __builtin_amdgcn_cvt_pk_u8_f32(__builtin_rintf(255.f * sigmoidf_(d)), 3, w); }
    __device__ __forceinline__ void operator()(const f32x4 (&acc)[2][2][4][2], const Unit& u, int wr, int wc, int fr, int fq) const {
        const int row0 = u.pm * BM + wr * 64 + fr, col0 = u.pn * BM + wc * 32 + 8 * fq;
        typedef unsigned u32x2_ __attribute__((ext_vector_type(2)));
#pragma unroll
        for (int ai = 0; ai < 2; ++ai)
#pragma unroll
            for (int m = 0; m < 4; ++m) { unsigned char* rp = MG + (size_t)(row0 + ai * HALF + m * 16) * 6144 + col0;
#pragma unroll
                for (int bj = 0; bj < 2; ++bj) { const f32x4 v0 = acc[ai][bj][m][0], v1 = acc[ai][bj][m][1];
                    u32x2_ w; w.x = q8(v0[0], v0[1], v0[2], v0[3]); w.y = q8(v1[0], v1[1], v1[2], v1[3]);
                    *(u32x2_*)(rp + bj * HALF) = w; } }
    }
};
struct EpiBranch {
    static constexpr int SCALE_W = 0x79797979, SCALE_A = 0x7b7b7b7b;
    static constexpr bool PERM = true, AFTER_DRAIN = false;
    const unsigned char* MG; unsigned char* Z;
    __device__ __forceinline__ bool keep_acc(const Unit& u) const { return (u.pn >> 3) < 2; }
    __device__ __forceinline__ int nst(const Unit&) const { return 0; }
    __device__ __forceinline__ void operator()(f32x4 (&acc)[2][2][4][2], const Unit& u, int wr, int wc, int fr, int fq) const {
        const int mm = u.pn >> 3, pn = u.pn & 7, pm = u.pm & 31; const int row0 = pm * BM + wr * 64 + fr;
#pragma unroll
        for (int ai = 0; ai < 2; ++ai)
#pragma unroll
            for (int m = 0; m < 4; ++m) { const int row = row0 + ai * HALF + m * 16;
#pragma unroll
                for (int bj = 0; bj < 2; ++bj) { const int col = pn * BM + bj * HALF + wc * 32 + 8 * fq;
                    typedef unsigned u32x2_ __attribute__((ext_vector_type(2)));
                    const unsigned char* gp = MG + (size_t)row * 6144 + mm * 2048 + col;
                    const u32x2_ ga = *(const u32x2_*)gp; u32x2_ gb = ga; if (mm < 2) gb = *(const u32x2_*)(gp + 2048);
                    float f[8]; const unsigned wa[2] = {ga.x, ga.y}, wb[2] = {gb.x, gb.y};
#pragma unroll
                    for (int e = 0; e < 8; ++e) { const float a0 = (float)((wa[e >> 2] >> (8 * (e & 3))) & 255u), b0 = fmaxf((float)((wb[e >> 2] >> (8 * (e & 3))) & 255u), 1e-20f);
                        if (mm == 0) f[e] = a0 * __builtin_amdgcn_rcpf(b0);
                        else if (mm == 1) f[e] = fmaxf(a0, 1e-20f) * __builtin_amdgcn_rcpf(b0);
                        else f[e] = fmaxf(a0, 1e-20f) * (16.0f / 255.0f); }
                    f32x4 v0 = acc[ai][bj][m][0], v1 = acc[ai][bj][m][1];
                    v0[0] *= f[0]; v0[1] *= f[1]; v0[2] *= f[2]; v0[3] *= f[3]; v1[0] *= f[4]; v1[1] *= f[5]; v1[2] *= f[6]; v1[3] *= f[7];
                    if (mm < 2) { acc[ai][bj][m][0] = v0; acc[ai][bj][m][1] = v1; }
                    else { int w0 = __builtin_amdgcn_cvt_pk_fp8_f32(v0[0], v0[1], 0, false); w0 = __builtin_amdgcn_cvt_pk_fp8_f32(v0[2], v0[3], w0, true);
                        int w1 = __builtin_amdgcn_cvt_pk_fp8_f32(v1[0], v1[1], 0, false); w1 = __builtin_amdgcn_cvt_pk_fp8_f32(v1[2], v1[3], w1, true);
                        u32x2_ w; w.x = (unsigned)w0; w.y = (unsigned)w1; *(u32x2_*)(Z + (size_t)row * 2048 + col) = w; } } }
    }
};
struct EpiResid {
    static constexpr int SCALE_W = 0x7f7f7f7f, SCALE_A = 0x7f7f7f7f;
    __device__ __forceinline__ bool keep_acc(const Unit&) const { return false; }
    static constexpr bool PERM = false, AFTER_DRAIN = false;
    const float* Xin; float* Xout;
    __device__ __forceinline__ void operator()(const f32x4 (&acc)[2][2][4][2], const Unit& u, int wr, int wc, int fr, int fq) const {
        const int row0 = u.pm * BM + wr * 64 + fr, col0 = u.pn * BM + wc * 32 + 4 * fq;
#pragma unroll
        for (int ai = 0; ai < 2; ++ai)
#pragma unroll
            for (int m = 0; m < 4; ++m) { const size_t ro = (size_t)(row0 + ai * HALF + m * 16) * 2048;
#pragma unroll
                for (int bj = 0; bj < 2; ++bj)
#pragma unroll
                    for (int n = 0; n < 2; ++n) { const size_t o = ro + col0 + bj * HALF + n * 16;
                        *(f32x4*)(Xout + o) = *(const f32x4*)(Xin + o) + acc[ai][bj][m][n]; } }
    }
};
struct EpiResidN {
    static constexpr int SCALE_W = 0x79797979, SCALE_A = 0x7b7b7b7b;
    __device__ __forceinline__ bool keep_acc(const Unit&) const { return false; }
    static constexpr bool PERM = false, AFTER_DRAIN = true;
    const float* Xin; float* Xout; const float* gain; bf16_t* Hp; float* SS;
    __device__ __forceinline__ void operator()(const f32x4 (&)[2][2][4][2], const Unit&, int, int, int, int) const {}
    __device__ __forceinline__ void fused(const f32x4 (&acc)[2][2][4][2], const Unit& u, int wr, int wc, int fr, int fq, PG8_LAS unsigned char* lds, int wid, int lane) const {
        const int row0 = u.pm * BM + wr * 64 + fr, col0 = u.pn * BM + wc * 32 + 4 * fq;
        PG8_LAS float* red = (PG8_LAS float*)lds;
#pragma unroll
        for (int ai = 0; ai < 2; ++ai)
#pragma unroll
            for (int m = 0; m < 4; ++m) { const size_t ro = (size_t)(row0 + ai * HALF + m * 16) * 2048; float ss = 0.f;
#pragma unroll
                for (int bj = 0; bj < 2; ++bj)
#pragma unroll
                    for (int n = 0; n < 2; ++n) { const size_t o = ro + col0 + bj * HALF + n * 16;
                        const f32x4 x = *(const f32x4*)(Xin + o) + acc[ai][bj][m][n]; *(f32x4*)(Xout + o) = x;
                        const f32x4 g = *(const f32x4*)(gain + col0 + bj * HALF + n * 16);
                        ss += (x[0] * x[0] + x[1] * x[1]) + (x[2] * x[2] + x[3] * x[3]);
                        typedef unsigned u32x2_ __attribute__((ext_vector_type(2)));
                        u32x2_ h; h.x = pk_bf16(x[0] * g[0], x[1] * g[1]); h.y = pk_bf16(x[2] * g[2], x[3] * g[3]); *(u32x2_*)(Hp + o) = h; }
                ss += __shfl_xor(ss, 16); ss += __shfl_xor(ss, 32);
                if (fq == 0) red[(ai * HALF + wr * 64 + m * 16 + fr) * 4 + wc] = ss; }
        asm volatile("s_waitcnt lgkmcnt(0)" ::: "memory"); __builtin_amdgcn_s_barrier(); asm volatile("" ::: "memory");
        const int t = wid * 64 + lane;
        if (t < 256) { const f32x4 p = *(const PG8_LAS f32x4*)(red + t * 4); SS[(size_t)(u.pm * BM + t) * 8 + u.pn] = (p[0] + p[1]) + (p[2] + p[3]); }
    }
};
struct EpiResidS {
    static constexpr int SCALE_W = 0x7f7f7f7f, SCALE_A = 0x7f7f7f7f;
    __device__ __forceinline__ bool keep_acc(const Unit&) const { return false; }
    static constexpr bool PERM = false, AFTER_DRAIN = false;
    float* X; const float* SS;
    __device__ __forceinline__ void operator()(const f32x4 (&acc)[2][2][4][2], const Unit& u, int wr, int wc, int fr, int fq) const {
        const int row0 = u.pm * BM + wr * 64 + fr, col0 = u.pn * BM + wc * 32 + 4 * fq;
        float r2[2][4];
#pragma unroll
        for (int ai = 0; ai < 2; ++ai)
#pragma unroll
            for (int m = 0; m < 4; ++m) { const float* sp = SS + (size_t)(row0 + ai * HALF + m * 16) * 8; const f32x4 a = *(const f32x4*)sp, b = *(const f32x4*)(sp + 4);
                const float s = ((a[0] + a[1]) + (a[2] + a[3])) + ((b[0] + b[1]) + (b[2] + b[3])); r2[ai][m] = 1.0f / (s * (1.0f / 2048.0f) + 1e-6f); }
#pragma unroll
        for (int ai = 0; ai < 2; ++ai)
#pragma unroll
            for (int m = 0; m < 4; ++m) { const size_t ro = (size_t)(row0 + ai * HALF + m * 16) * 2048;
#pragma unroll
                for (int bj = 0; bj < 2; ++bj)
#pragma unroll
                    for (int n = 0; n < 2; ++n) { const size_t o = ro + col0 + bj * HALF + n * 16;
                        *(f32x4*)(X + o) = *(const f32x4*)(X + o) + acc[ai][bj][m][n] * r2[ai][m]; } }
    }
};
struct EpiResidSX {
    static constexpr int SCALE_W = 0x7f7f7f7f, SCALE_A = 0x7f7f7f7f;
    __device__ __forceinline__ bool keep_acc(const Unit&) const { return false; }
    static constexpr bool PERM = false, AFTER_DRAIN = true;
    float* X; const float* SS; float* XCH; unsigned* CNT; const float* gain; bf16_t* H; unsigned char* H8; float* OUT; int last;
    __device__ __forceinline__ void operator()(const f32x4 (&)[2][2][4][2], const Unit&, int, int, int, int) const {}
    __device__ __forceinline__ void fused(f32x4 (&acc)[2][2][4][2], const Unit& u, int wr, int wc, int fr, int fq, PG8_LAS unsigned char* lds, int wid, int lane) const {
        typedef __attribute__((address_space(1))) unsigned gu32_;
        typedef unsigned u32x2_ __attribute__((ext_vector_type(2)));
        const int row0 = u.pm * BM + wr * 64 + fr, col0 = u.pn * BM + wc * 32 + 4 * fq;
        PG8_LAS float* red = (PG8_LAS float*)lds;
        PG8_LAS float* rstd = (PG8_LAS float*)(lds + 4096);
#pragma unroll
        for (int ai = 0; ai < 2; ++ai)
#pragma unroll
            for (int m = 0; m < 4; ++m) { const int row = row0 + ai * HALF + m * 16; const float* sp = SS + (size_t)row * 8; const f32x4 a = *(const f32x4*)sp, b = *(const f32x4*)(sp + 4);
                const float s = ((a[0] + a[1]) + (a[2] + a[3])) + ((b[0] + b[1]) + (b[2] + b[3])), r2 = 1.0f / (s * (1.0f / 2048.0f) + 1e-6f); float ss = 0.f;
#pragma unroll
                for (int bj = 0; bj < 2; ++bj)
#pragma unroll
                    for (int n = 0; n < 2; ++n) { const size_t o = (size_t)row * 2048 + col0 + bj * HALF + n * 16;
                        const f32x4 x = *(const f32x4*)(X + o) + acc[ai][bj][m][n] * r2; acc[ai][bj][m][n] = x;
                        if (!last) *(f32x4*)(X + o) = x;
                        ss += (x[0] * x[0] + x[1] * x[1]) + (x[2] * x[2] + x[3] * x[3]); }
                ss += __shfl_xor(ss, 16); ss += __shfl_xor(ss, 32);
                if (fq == 0) red[(ai * HALF + wr * 64 + m * 16 + fr) * 4 + wc] = ss; }
        asm volatile("s_waitcnt lgkmcnt(0)" ::: "memory"); __builtin_amdgcn_s_barrier(); asm volatile("" ::: "memory");
        const int t = wid * 64 + lane;
        if (t < 256) { const f32x4 p = *(const PG8_LAS f32x4*)(red + t * 4); const float v = (p[0] + p[1]) + (p[2] + p[3]);
            __hip_atomic_store((gu32_*)(XCH + (size_t)(u.pm * BM + t) * 8 + u.pn), __builtin_bit_cast(unsigned, v), __ATOMIC_RELAXED, __HIP_MEMORY_SCOPE_AGENT); }
        asm volatile("s_waitcnt vmcnt(0)" ::: "memory"); __builtin_amdgcn_s_barrier(); asm volatile("" ::: "memory");
        if (t == 0) { gu32_* c = (gu32_*)(CNT + 64 * u.pm);
            (void)__hip_atomic_fetch_add(c, 1u, __ATOMIC_RELAXED, __HIP_MEMORY_SCOPE_AGENT);
            unsigned spins = 0; while (__hip_atomic_load(c, __ATOMIC_RELAXED, __HIP_MEMORY_SCOPE_AGENT) < 8u && ++spins < (1u << 22)) __builtin_amdgcn_s_sleep(1);
            __builtin_amdgcn_fence(__ATOMIC_ACQUIRE, "agent"); asm volatile("s_waitcnt vmcnt(0)" ::: "memory"); }
        asm volatile("s_waitcnt lgkmcnt(0)" ::: "memory"); __builtin_amdgcn_s_barrier(); asm volatile("" ::: "memory");
        if (t < 256) { float s = 0.f;
#pragma unroll
            for (int j = 0; j < 8; ++j) s += __builtin_bit_cast(float, __hip_atomic_load((gu32_*)(XCH + (size_t)(u.pm * BM + t) * 8 + j), __ATOMIC_RELAXED, __HIP_MEMORY_SCOPE_AGENT));
            rstd[t] = 1.0f / sqrtf(s * (1.0f / 2048.0f) + 1e-6f); }
        asm volatile("s_waitcnt lgkmcnt(0)" ::: "memory"); __builtin_amdgcn_s_barrier(); asm volatile("" ::: "memory");
#pragma unroll
        for (int ai = 0; ai < 2; ++ai)
#pragma unroll
            for (int m = 0; m < 4; ++m) { const int rl = ai * HALF + wr * 64 + m * 16 + fr; const float r = rstd[rl]; const size_t ro = (size_t)(u.pm * BM + rl) * 2048;
#pragma unroll
                for (int bj = 0; bj < 2; ++bj)
#pragma unroll
                    for (int n = 0; n < 2; ++n) { const int c = col0 + bj * HALF + n * 16; const f32x4 g = *(const f32x4*)(gain + c); const f32x4 x = acc[ai][bj][m][n];
                        const f32x4 y = {x[0] * r * g[0], x[1] * r * g[1], x[2] * r * g[2], x[3] * r * g[3]};
                        if (last) *(f32x4*)(OUT + ro + c) = y;
                        else { int w = __builtin_amdgcn_cvt_pk_fp8_f32(y[0], y[1], 0, false); w = __builtin_amdgcn_cvt_pk_fp8_f32(y[2], y[3], w, true); *(unsigned*)(H8 + ro + c) = (unsigned)w; } } }
    }
};
struct EpiRelu2 {
    static constexpr int SCALE_W = 0x7f7f7f7f, SCALE_A = 0x7f7f7f7f;
    __device__ __forceinline__ bool keep_acc(const Unit&) const { return false; }
    __device__ __forceinline__ int nst(const Unit&) const { return 16; }
    static constexpr bool PERM = true, AFTER_DRAIN = false;
    bf16_t* U;
    __device__ __forceinline__ void operator()(const f32x4 (&acc)[2][2][4][2], const Unit& u, int wr, int wc, int fr, int fq) const {
        const int row0 = u.pm * BM + wr * 64 + fr, col0 = u.pn * BM + wc * 32 + 8 * fq;
#pragma unroll
        for (int ai = 0; ai < 2; ++ai)
#pragma unroll
            for (int m = 0; m < 4; ++m) { bf16_t* rp = U + (size_t)(row0 + ai * HALF + m * 16) * 8192 + col0;
#pragma unroll
                for (int bj = 0; bj < 2; ++bj) { f32x4 v0 = acc[ai][bj][m][0], v1 = acc[ai][bj][m][1];
#pragma unroll
                    for (int e = 0; e < 4; ++e) { const float a = fmaxf(v0[e], 0.f), b = fmaxf(v1[e], 0.f); v0[e] = a * a; v1[e] = b * b; }
                    u32x4 w; w.x = pk_bf16(v0[0], v0[1]); w.y = pk_bf16(v0[2], v0[3]); w.z = pk_bf16(v1[0], v1[1]); w.w = pk_bf16(v1[2], v1[3]);
                    *(u32x4*)(rp + bj * HALF) = w; } }
    }
};
struct EpiPart {
    static constexpr int SCALE_W = 0x7f7f7f7f, SCALE_A = 0x7f7f7f7f;
    __device__ __forceinline__ bool keep_acc(const Unit&) const { return false; }
    static constexpr bool PERM = false, AFTER_DRAIN = false;
    float* PART;
    __device__ __forceinline__ void operator()(const f32x4 (&acc)[2][2][4][2], const Unit& u, int wr, int wc, int fr, int fq) const {
        const int kv = u.pn, kc = u.ko >> 9, row0 = (u.pm & 3) * BM + wr * 64 + fr, col0 = wc * 32 + 4 * fq;
        float* base = PART + (size_t)(kc * 2 + kv) * 1024 * 256;
#pragma unroll
        for (int ai = 0; ai < 2; ++ai)
#pragma unroll
            for (int m = 0; m < 4; ++m) { float* rp = base + (size_t)(row0 + ai * HALF + m * 16) * 256 + col0;
#pragma unroll
                for (int bj = 0; bj < 2; ++bj)
#pragma unroll
                    for (int n = 0; n < 2; ++n) *(f32x4*)(rp + bj * HALF + n * 16) = acc[ai][bj][m][n]; }
    }
};
struct CmpOrder {
    int c;
    __device__ bool next(int i, Unit& u) const { if (i != 0 || c >= 64) return false; const int kv = c >> 5; u.pm = kv * 4 + ((c >> 3) & 3); u.pn = kv; u.ko = (c & 7) * 512; return true; }
    __device__ __forceinline__ void a_ready(const Unit&) const {}
    __device__ __forceinline__ void done(const Unit&) const {}
};
struct BranchOrder {
    StaticOrder S;
    __device__ bool next(int i, Unit& u) const { Unit t; if (!S.next(i / 3, t)) return false; const int mm = i % 3; u.pm = mm * 32 + t.pm; u.pn = mm * 8 + t.pn; u.ko = 0; return true; }
    __device__ __forceinline__ void a_ready(const Unit&) const {}
    __device__ __forceinline__ void done(const Unit&) const {}
};
template <class Epi, class Sched, bool ALIGN_EPI = false, bool SP2 = false, bool F8 = false>
__device__ __forceinline__ void gemm_phase(PG8_LAS unsigned char* lds, const Gemm g, const Sched& S, const Epi& E) {
    int tid_o = threadIdx.x; asm volatile("" : "+v"(tid_o));
    const int tid = tid_o, wid = __builtin_amdgcn_readfirstlane(tid >> 6), lane = tid & 63, wr = wid >> 2, wc = wid & 3, fr = lane & 15, fq = lane >> 4;
    const int K = g.K, nt = K / BK;
    unsigned voffA[2], voffB[2];
#pragma unroll
    for (int i = 0; i < 2; ++i) { int R, C; stage_rc(tid * 16 + i * 8192, R, C); const int Rb = Epi::PERM ? ((R & ~31) + perm32(R & 31)) : R;
        voffA[i] = (unsigned)(R * g.lda + C) * 2u; voffB[i] = (unsigned)(Rb * g.ldb + C) * 2u; }
    const size_t kstep = (size_t)(BK * 2);
    const size_t hstepA = (size_t)HALF * g.lda * 2, hstepB = (size_t)HALF * g.ldb * 2;
    const size_t tstepA = 2 * hstepA, tstepB = 2 * hstepB;
    const unsigned ldsw = (unsigned)wid * 1024u;
    const int aoff = lds_byte(wr * 64 + fr, fq * 8), boff = lds_byte(wc * 32 + fr, fq * 8);
    constexpr int KSTR = 1024;
    const int scale_w_ = Epi::SCALE_W, scale_a_ = Epi::SCALE_A; (void)scale_w_; (void)scale_a_;
#define PG8_SA(b, h) (((b) * 2 + (h)) * HTB)
#define PG8_SB(b, h) ((4 + (b) * 2 + (h)) * HTB)
#define PG8_STAGE(bufoff, gbase, voff) do { _Pragma("unroll") for (int _i = 0; _i < 2; ++_i) \
        __builtin_amdgcn_global_load_lds((const unsigned*)((const char*)(gbase) + (voff)[_i]), (PG8_LAS unsigned*)(lds + (bufoff) + ldsw + _i * 8192), 16, 0, 0); } while (0)
#define PG8_LDA(dst, b, h) do { _Pragma("unroll") for (int m = 0; m < 4; ++m) _Pragma("unroll") for (int k = 0; k < 2; ++k) dst[m][k] = *(const PG8_LAS bf16x8*)(lds + PG8_SA(b, h) + aoff + m * 2048 + k * KSTR); } while (0)
#define PG8_LDB(dst, b, h) do { _Pragma("unroll") for (int n = 0; n < 2; ++n) _Pragma("unroll") for (int k = 0; k < 2; ++k) dst[n][k] = *(const PG8_LAS bf16x8*)(lds + PG8_SB(b, h) + boff + n * 2048 + k * KSTR); } while (0)
#define PG8_MMA(ai, bj, At, Bt) do { __builtin_amdgcn_s_setprio(1); \
        if constexpr (F8) { _Pragma("unroll") for (int m = 0; m < 4; ++m) _Pragma("unroll") for (int n = 0; n < 2; ++n) \
            asm volatile("v_mfma_scale_f32_16x16x128_f8f6f4 %0, %1, %2, %0, %3, %4 op_sel_hi:[0,0,0]" : "+v"(acc[ai][bj][m][n]) \
                : "v"(__builtin_bit_cast(i32x8, __builtin_shufflevector(Bt[n][0], Bt[n][1], 0, 1, 2, 3, 4, 5, 6, 7, 8, 9, 10, 11, 12, 13, 14, 15))), \
                  "v"(__builtin_bit_cast(i32x8, __builtin_shufflevector(At[m][0], At[m][1], 0, 1, 2, 3, 4, 5, 6, 7, 8, 9, 10, 11, 12, 13, 14, 15))), "v"(scale_w_), "v"(scale_a_)); } \
        else { _Pragma("unroll") for (int m = 0; m < 4; ++m) _Pragma("unroll") for (int n = 0; n < 2; ++n) _Pragma("unroll") for (int k = 0; k < 2; ++k) \
            acc[ai][bj][m][n] = __builtin_amdgcn_mfma_f32_16x16x32_bf16(Bt[n][k], At[m][k], acc[ai][bj][m][n], 0, 0, 0); } \
        __builtin_amdgcn_s_setprio(0); } while (0)
#define PG8_WAIT_V(n) asm volatile("s_waitcnt vmcnt(" #n ")" ::: "memory")
#define PG8_WAIT_L(n) asm volatile("s_waitcnt lgkmcnt(" #n ")" ::: "memory")
#define PG8_BAR __builtin_amdgcn_s_barrier()
#define PG8_SCHED __builtin_amdgcn_sched_barrier(0)
    Unit cur, nxt; int ui = 0, fl = 0;
    if (!S.next(0, cur)) return;
    f32x4 acc[2][2][4][2];
#pragma unroll
    for (int a = 0; a < 2; ++a)
#pragma unroll
        for (int b = 0; b < 2; ++b)
#pragma unroll
            for (int m = 0; m < 4; ++m)
#pragma unroll
                for (int n = 0; n < 2; ++n) acc[a][b][m][n] = (f32x4){0.f, 0.f, 0.f, 0.f};
    bf16x8 At[4][2], B0[2][2], B1[2][2];
    const char* cA = (const char*)g.A + (size_t)cur.pm * tstepA + (size_t)cur.ko * 2; const char* cB = (const char*)g.Bt + (size_t)cur.pn * tstepB + (size_t)cur.ko * 2;
    S.a_ready(cur);
    if constexpr (SP2) {
        PG8_STAGE(PG8_SB(0, 0), cB, voffB); PG8_STAGE(PG8_SB(0, 1), cB + hstepB, voffB); PG8_STAGE(PG8_SA(0, 0), cA, voffA); PG8_STAGE(PG8_SA(0, 1), cA + hstepA, voffA);
        if (wr == 1) PG8_BAR;
        PG8_WAIT_V(2); PG8_BAR;
        PG8_STAGE(PG8_SB(1, 0), cB + kstep, voffB); PG8_STAGE(PG8_SA(1, 0), cA + kstep, voffA); PG8_STAGE(PG8_SB(1, 1), cB + hstepB + kstep, voffB);
        PG8_WAIT_V(6); PG8_BAR;
    } else {
        PG8_STAGE(PG8_SB(0, 0), cB, voffB); PG8_STAGE(PG8_SA(0, 0), cA, voffA); PG8_STAGE(PG8_SB(0, 1), cB + hstepB, voffB); PG8_STAGE(PG8_SA(0, 1), cA + hstepA, voffA);
        if (wr == 1) PG8_BAR;
        PG8_WAIT_V(4); PG8_BAR;
        PG8_STAGE(PG8_SB(1, 0), cB + kstep, voffB); PG8_STAGE(PG8_SA(1, 0), cA + kstep, voffA); PG8_STAGE(PG8_SB(1, 1), cB + hstepB + kstep, voffB);
        PG8_WAIT_V(6); PG8_BAR;
    }
    for (;;) {
        const bool has_next = S.next(ui + 1, nxt);
        const char* nA = has_next ? (const char*)g.A + (size_t)nxt.pm * tstepA + (size_t)nxt.ko * 2 : cA; const char* nB = has_next ? (const char*)g.Bt + (size_t)nxt.pn * tstepB + (size_t)nxt.ko * 2 : cB;
#pragma clang loop unroll(disable)
        for (int t = 0; t < nt; t += 2) {
            const bool last = (t == nt - 2);
            int fl_ = fl; asm volatile("" : "+s"(fl_)); fl = 0;
            const bool first = fl_ & 1;
            const bool rlx = fl_ & 2;
            const char* a1 = cA + (size_t)(t + 1) * kstep;
            const char* a2 = last ? nA : cA + (size_t)(t + 2) * kstep; const char* b2 = last ? nB : cB + (size_t)(t + 2) * kstep;
            const char* a3 = a2 + kstep; const char* b3 = b2 + kstep;
            if (last && has_next) S.a_ready(nxt);
            if constexpr (SP2) {
            PG8_LDB(B0, 0, 0); PG8_LDB(B1, 0, 1); PG8_SCHED; PG8_LDA(At, 0, 0); if (!first) PG8_STAGE(PG8_SA(1, 1), a1 + hstepA, voffA);
            if (rlx) PG8_WAIT_V(24); else PG8_WAIT_V(8);
            PG8_WAIT_L(0); PG8_BAR; PG8_MMA(0, 0, At, B0); PG8_MMA(0, 1, At, B1); PG8_BAR; PG8_SCHED;
            PG8_LDA(At, 0, 1); PG8_STAGE(PG8_SB(0, 0), b2, voffB); PG8_STAGE(PG8_SB(0, 1), b2 + hstepB, voffB); PG8_STAGE(PG8_SA(0, 0), a2, voffA);
            if (rlx) PG8_WAIT_V(24); else PG8_WAIT_V(8);
            PG8_WAIT_L(0); PG8_BAR; PG8_MMA(1, 0, At, B0); PG8_MMA(1, 1, At, B1); PG8_BAR; PG8_SCHED;
            PG8_LDB(B0, 1, 0); PG8_LDB(B1, 1, 1); PG8_SCHED; PG8_LDA(At, 1, 0); PG8_STAGE(PG8_SA(0, 1), a2 + hstepA, voffA);
            if (rlx) PG8_WAIT_V(24); else PG8_WAIT_V(8);
            PG8_WAIT_L(0); PG8_BAR; PG8_MMA(0, 0, At, B0); PG8_MMA(0, 1, At, B1); PG8_BAR; PG8_SCHED;
            PG8_LDA(At, 1, 1); PG8_STAGE(PG8_SB(1, 0), b3, voffB); PG8_STAGE(PG8_SB(1, 1), b3 + hstepB, voffB); PG8_STAGE(PG8_SA(1, 0), a3, voffA);
            PG8_WAIT_V(8); PG8_WAIT_L(0); PG8_BAR; PG8_MMA(1, 0, At, B0); PG8_MMA(1, 1, At, B1); PG8_BAR; PG8_SCHED;
            } else {
            PG8_LDB(B0, 0, 0); PG8_SCHED; PG8_LDA(At, 0, 0); PG8_STAGE(PG8_SA(1, 1), a1 + hstepA, voffA);
            PG8_WAIT_L(8); PG8_BAR; PG8_WAIT_L(0); PG8_MMA(0, 0, At, B0); PG8_BAR; PG8_SCHED;
            PG8_LDB(B1, 0, 1); PG8_STAGE(PG8_SB(0, 0), b2, voffB);
            PG8_BAR; PG8_WAIT_L(0); PG8_MMA(0, 1, At, B1); PG8_BAR;
            PG8_LDA(At, 0, 1); PG8_STAGE(PG8_SA(0, 0), a2, voffA);
            PG8_BAR; PG8_WAIT_L(0); PG8_MMA(1, 0, At, B0); PG8_BAR; PG8_SCHED;
            PG8_STAGE(PG8_SB(0, 1), b2 + hstepB, voffB);
            PG8_WAIT_V(6); PG8_BAR; PG8_MMA(1, 1, At, B1); PG8_BAR;
            PG8_LDB(B0, 1, 0); PG8_SCHED; PG8_LDA(At, 1, 0); PG8_STAGE(PG8_SA(0, 1), a2 + hstepA, voffA);
            PG8_WAIT_L(8); PG8_BAR; PG8_WAIT_L(0); PG8_MMA(0, 0, At, B0); PG8_BAR; PG8_SCHED;
            PG8_LDB(B1, 1, 1); PG8_STAGE(PG8_SB(1, 0), b3, voffB);
            PG8_BAR; PG8_WAIT_L(0); PG8_MMA(0, 1, At, B1); PG8_BAR;
            PG8_LDA(At, 1, 1); PG8_STAGE(PG8_SA(1, 0), a3, voffA);
            PG8_BAR; PG8_WAIT_L(0); PG8_MMA(1, 0, At, B0); PG8_BAR; PG8_SCHED;
            PG8_STAGE(PG8_SB(1, 1), b3 + hstepB, voffB);
            PG8_WAIT_V(6); PG8_BAR; PG8_MMA(1, 1, At, B1); PG8_BAR;
            }
        }
        if constexpr (ALIGN_EPI) { if (wr == 0) PG8_BAR; }
        if constexpr (ALIGN_EPI && SP2) { if (has_next) PG8_STAGE(PG8_SA(1, 1), nA + kstep + hstepA, voffA); }
        if constexpr (F8) asm volatile("s_nop 15\n\ts_nop 15\n\ts_nop 15" ::: "memory");
        if constexpr (!Epi::AFTER_DRAIN) { E(acc, cur, wr, wc, fr, fq); S.done(cur); }
        if (!has_next) break;
        if (!E.keep_acc(cur)) {
#pragma unroll
        for (int a = 0; a < 2; ++a)
#pragma unroll
            for (int b = 0; b < 2; ++b)
#pragma unroll
                for (int m = 0; m < 4; ++m)
#pragma unroll
                    for (int n = 0; n < 2; ++n) acc[a][b][m][n] = (f32x4){0.f, 0.f, 0.f, 0.f};
        }
        if constexpr (ALIGN_EPI && SP2) fl = E.nst(cur) >= 16 ? 3 : 1;
        cur = nxt; cA = nA; cB = nB; ++ui;
        if constexpr (ALIGN_EPI) { if (wr == 1) PG8_BAR; }
    }
    PG8_WAIT_V(0);
    if constexpr (!ALIGN_EPI) { if (wr == 0) PG8_BAR; }
    PG8_BAR;
    if constexpr (Epi::AFTER_DRAIN) { E.fused(acc, cur, wr, wc, fr, fq, lds, wid, lane); S.done(cur); }
#undef PG8_SA
#undef PG8_SB
#undef PG8_STAGE
#undef PG8_LDA
#undef PG8_LDB
#undef PG8_MMA
#undef PG8_WAIT_V
#undef PG8_WAIT_L
#undef PG8_BAR
#undef PG8_SCHED
}
}
constexpr int NB = 4, SEQ = 2048, DM = 2048, DEPTH = 4, DFF = 8192, DIN = 11800, DINP = 12032  ;
static_assert(NB * SEQ == pg8::TOK, "tokens");
constexpr int NWAVES = 8;
constexpr size_t MiB = 1u << 20;
constexpr size_t WS_CTL = 0, CTL_ZERO_BYTES = 192 * 1024;
constexpr size_t WS_WIN8 = 2 * MiB;
constexpr size_t WS_H8 = 146 * MiB;
constexpr size_t WS_WBR = 190 * MiB;
constexpr size_t WS_WOUT = 238 * MiB;
constexpr size_t WS_WMI = 270 * MiB;
constexpr size_t WS_WMO = 398 * MiB;
constexpr size_t WS_CW1 = 526 * MiB;
constexpr size_t WS_CW2 = 542 * MiB;
constexpr size_t WS_CBP = 543 * MiB;
constexpr size_t WS_X = 544 * MiB;
constexpr size_t WS_H = 608 * MiB;
constexpr size_t WS_Q = 640 * MiB;
constexpr size_t WS_KV = 688 * MiB;
constexpr size_t WS_MG = 729 * MiB;
constexpr size_t WS_AG = 825 * MiB;
constexpr size_t WS_KC = 826 * MiB;
constexpr size_t WS_O = 827 * MiB;
constexpr size_t WS_O8 = 875 * MiB;
constexpr size_t WS_Z = 939 * MiB;
constexpr size_t WS_U = 971 * MiB;
constexpr size_t WS_PART = 1099 * MiB;
constexpr size_t WS_SS = 1115 * MiB;
constexpr size_t WS_XCH = 1116 * MiB;
constexpr size_t WS_END = 1117 * MiB;
constexpr int CW_BAR = 4096;
constexpr int CW_CNT = 32768;
constexpr int CW_WQ = 16384;
constexpr int RING_OFF = 0, RING_BYTES = 131072;
constexpr int LDSCTL_OFF = RING_BYTES, MISC_OFF = LDSCTL_OFF + 320;
constexpr int LDS_BYTES = 147456;
static_assert(MISC_OFF + 128 <= LDS_BYTES, "LDS map");

#define GAS __attribute__((address_space(1)))
#define LAS __attribute__((address_space(3)))
typedef unsigned short bf16;
typedef unsigned v4u __attribute__((ext_vector_type(4)));
typedef unsigned v2u __attribute__((ext_vector_type(2)));
typedef float f32x4 __attribute__((ext_vector_type(4)));
typedef float f32x16 __attribute__((ext_vector_type(16)));
typedef short bf16x8 __attribute__((ext_vector_type(8)));
typedef short s16x4 __attribute__((ext_vector_type(4)));
typedef GAS unsigned gu32;
#define RLX_AGENT __ATOMIC_RELAXED, __HIP_MEMORY_SCOPE_AGENT
#define LDS_WAIT() asm volatile("s_waitcnt lgkmcnt(0)" ::: "memory")
#define VM_WAIT() asm volatile("s_waitcnt vmcnt(0)" ::: "memory")
using pg8::pk_bf16; using pg8::bf_lo; using pg8::bf_hi;

#define XB_TMO      128
#define XB_XCNT(j)  (256  + 64 * (j))
#define XB_XSUB(j)  (1280 + 64 * (j))
#define XB_XGEN(j)  (2304 + 64 * (j))
#define XB_TOP      3328
#define XB_TOPGEN   3392
#define XCD_BAR_WORDS 3456
#define XB_SPIN_CAP (1u << 18)

__device__ __forceinline__ unsigned xb_ld(unsigned* p)              { return __hip_atomic_load(p, __ATOMIC_RELAXED, __HIP_MEMORY_SCOPE_AGENT); }
__device__ __forceinline__ unsigned xb_add(unsigned* p, unsigned v) { return __hip_atomic_fetch_add(p, v, __ATOMIC_RELAXED, __HIP_MEMORY_SCOPE_AGENT); }
__device__ __forceinline__ unsigned xb_xcc_id() { return (unsigned)__builtin_amdgcn_s_getreg((3 << 11) | 20) & 0xFu; }
#define XB_SPIN(cond, bar) do { unsigned _sp = 0; while (cond) { __builtin_amdgcn_s_sleep(1); \
    if ((++_sp & 255u) == 0u) { if (xb_ld(&(bar)[XB_TMO])) break; if (_sp > XB_SPIN_CAP) { atomicAdd(&(bar)[XB_TMO], 1u); break; } } } } while (0)

struct XcdBarrier {
    unsigned* bar; unsigned x;
    volatile LAS unsigned* st;
};

__device__ __forceinline__ XcdBarrier xcd_barrier_post(unsigned* bar, volatile LAS unsigned* st) {
    XcdBarrier b; b.bar = bar; b.x = xb_xcc_id(); b.st = st;
    if (threadIdx.x == 0) (void)xb_add(&bar[XB_XCNT(b.x)], 1u);
    return b;
}
__device__ __forceinline__ void xcd_barrier_complete(unsigned* bar, unsigned x, unsigned& nloc, unsigned& nx) {
    const unsigned G = gridDim.x * gridDim.y * gridDim.z;
    unsigned sum, cnt, mine, sp = 0u;
    for (;;) {
        sum = 0u; cnt = 0u; mine = 0u;
#pragma unroll
        for (unsigned j = 0; j < 16; ++j) { const unsigned c = xb_ld(&bar[XB_XCNT(j)]); sum += c; cnt += (c > 0u) ? 1u : 0u; mine = (j == x) ? c : mine; }
        if (sum == G) break;
        __builtin_amdgcn_s_sleep(1);
        if ((++sp & 255u) == 0u) { if (xb_ld(&bar[XB_TMO])) break; if (sp > XB_SPIN_CAP) { atomicAdd(&bar[XB_TMO], 1u); break; } }
    }
    nloc = mine > 0u ? mine : 1u; nx = cnt > 0u ? cnt : 1u;
}

__device__ __forceinline__ void xcd_barrier(const XcdBarrier& b) {
    asm volatile("s_waitcnt vmcnt(0)" ::: "memory");
    __syncthreads();
    if (threadIdx.x == 0) {
        unsigned* bar = b.bar;
        __builtin_amdgcn_s_waitcnt(0);
        unsigned nloc = b.st[0], nx = b.st[1];
        if (nloc == 0u) { xcd_barrier_complete(bar, b.x, nloc, nx); b.st[0] = nloc; b.st[1] = nx; }
        const unsigned old = xb_add(&bar[XB_XSUB(b.x)], 1u);
        const unsigned gen = old / nloc;
        if (old + 1u == (gen + 1u) * nloc) {
            __builtin_amdgcn_fence(__ATOMIC_RELEASE, "agent");
            asm volatile("s_waitcnt vmcnt(0)" ::: "memory");
            const unsigned og = xb_add(&bar[XB_TOP], 1u);
            const unsigned tg = og / nx;
            if (og + 1u == (tg + 1u) * nx) xb_add(&bar[XB_TOPGEN], 1u);
            else XB_SPIN(xb_ld(&bar[XB_TOPGEN]) == tg, bar);
            __builtin_amdgcn_fence(__ATOMIC_ACQUIRE, "agent");
            xb_add(&bar[XB_XGEN(b.x)], 1u);
            asm volatile("s_waitcnt vmcnt(0)" ::: "memory");
        } else {
            XB_SPIN(xb_ld(&bar[XB_XGEN(b.x)]) == gen, bar);
            __builtin_amdgcn_fence(__ATOMIC_ACQUIRE, "agent");
            asm volatile("s_waitcnt vmcnt(0)" ::: "memory");
        }
    }
    __syncthreads();
}

__device__ __forceinline__ float wave_sum(float v) {
#pragma unroll
    for (int o = 1; o < 64; o <<= 1) v += __shfl_xor(v, o);
    return v;
}
__device__ __forceinline__ float xhalf_max(float v) { auto rr = __builtin_amdgcn_permlane32_swap(__float_as_uint(v), __float_as_uint(v), false, false); return fmaxf(__uint_as_float(rr[0]), __uint_as_float(rr[1])); }
__device__ __forceinline__ float xhalf_sum(float v) { auto rr = __builtin_amdgcn_permlane32_swap(__float_as_uint(v), __float_as_uint(v), false, false); return __uint_as_float(rr[0]) + __uint_as_float(rr[1]); }

template <int MODE>
__device__ __forceinline__ void p0_transpose_item(const float* W, int K, int N, bf16* WT, LAS float* scr, int item, int lane, const float* pos, float* cbp, unsigned char* W8 = nullptr) {
    const int nblk = (N + 31) / 32, kb = item / nblk, nb = item % nblk, k0 = 64 * kb, n0 = 32 * nb;
    {
        const int c4 = (lane & 7) * 4, nn = n0 + c4; const float* p = W + (size_t)(k0 + (lane >> 3)) * N + nn;
        f32x4 v[8];
#pragma unroll
        for (int i = 0; i < 8; ++i) v[i] = (nn < N) ? *(const f32x4*)(p + (size_t)(8 * i) * N) : (f32x4){0.f, 0.f, 0.f, 0.f};
#pragma unroll
        for (int i = 0; i < 8; ++i) { LAS float* d = scr + (8 * i + (lane >> 3)) * 33 + c4; d[0] = v[i].x; d[1] = v[i].y; d[2] = v[i].z; d[3] = v[i].w; }
    }
    LDS_WAIT(); asm volatile("" ::: "memory");
    if (MODE == 2) {
        const int hf = lane >> 5; float s = 0.f;
#pragma unroll 8
        for (int kk = 0; kk < 32; ++kk) s += pos[k0 + 32 * hf + kk] * scr[(32 * hf + kk) * 33 + (lane & 31)];
        s += __shfl_xor(s, 32);
        if (lane < 32) cbp[(size_t)kb * 256 + n0 + lane] = s;
    }
    const int c = lane & 7;
#pragma unroll
    for (int j = 0; j < 4; ++j) { const int n = (lane >> 3) + 8 * j; const LAS float* s = scr + (8 * c) * 33 + n; const int ng = n0 + n;
        if (MODE == 1 || MODE == 3) {
            if (ng < N) { const int dr8 = (MODE == 3) ? ng : ((ng < 2560) ? ng : ((ng < 2584) ? (11776 + ng - 2560) : (ng - 24)));
                int w0 = __builtin_amdgcn_cvt_pk_fp8_f32(s[0 * 33] * 64.f, s[1 * 33] * 64.f, 0, false); w0 = __builtin_amdgcn_cvt_pk_fp8_f32(s[2 * 33] * 64.f, s[3 * 33] * 64.f, w0, true);
                int w1 = __builtin_amdgcn_cvt_pk_fp8_f32(s[4 * 33] * 64.f, s[5 * 33] * 64.f, 0, false); w1 = __builtin_amdgcn_cvt_pk_fp8_f32(s[6 * 33] * 64.f, s[7 * 33] * 64.f, w1, true);
                *(GAS v2u*)(W8 + (size_t)dr8 * K + k0 + 8 * c) = (v2u){(unsigned)w0, (unsigned)w1}; }
            continue; }
        v4u o; o.x = pk_bf16(s[0 * 33], s[1 * 33]); o.y = pk_bf16(s[2 * 33], s[3 * 33]); o.z = pk_bf16(s[4 * 33], s[5 * 33]); o.w = pk_bf16(s[6 * 33], s[7 * 33]);
        const int dr = ng;
        if (ng < N) *(GAS v4u*)(WT + (size_t)dr * K + k0 + 8 * c) = o; }
    LDS_WAIT(); asm volatile("" ::: "memory");
}
template <bool F32OUT, bool Q8 = false>
__device__ __forceinline__ void rms_row(const float* xrow, const float* gain, bf16* orow, float* frow, int lane, unsigned* q8row = nullptr) {
    const GAS f32x4* xr = (const GAS f32x4*)xrow + lane; const GAS f32x4* gr = (const GAS f32x4*)gain + lane;
    f32x4 v[8]; float s = 0.f;
#pragma unroll
    for (int j = 0; j < 8; ++j) { v[j] = xr[64 * j]; s += (v[j].x * v[j].x + v[j].y * v[j].y) + (v[j].z * v[j].z + v[j].w * v[j].w); }
    const float r = 1.0f / sqrtf(wave_sum(s) * (1.0f / 2048.0f) + 1e-6f);
#pragma unroll
    for (int j = 0; j < 8; ++j) { const f32x4 g = gr[64 * j]; const f32x4 y = {v[j].x * r * g.x, v[j].y * r * g.y, v[j].z * r * g.z, v[j].w * r * g.w};
        if (F32OUT) ((GAS f32x4*)frow)[lane + 64 * j] = y;
        else { if (!Q8) { v2u o; o.x = pk_bf16(y.x, y.y); o.y = pk_bf16(y.z, y.w); ((GAS v2u*)orow)[lane + 64 * j] = o; }
            if (Q8) { int w = __builtin_amdgcn_cvt_pk_fp8_f32(y.x, y.y, 0, false); w = __builtin_amdgcn_cvt_pk_fp8_f32(y.z, y.w, w, true); ((GAS unsigned*)q8row)[lane + 64 * j] = (unsigned)w; } } }
}
namespace att {
constexpr float LOG2E = 1.4426950408889634f;
constexpr float QK_C = 0.08838834764831845f * LOG2E;
constexpr int L_K0 = 0, L_V0 = 16384, L_ST = 32768  , L_IMP = 65536, L_IMPS = 98304, L_B2 = 106752, L_SEL = 108800, L_WM = 109056, L_SLOT = 109088, L_PART = 109120;
constexpr int L_END = L_PART + 2048;
constexpr int L_B2ALL = 131072 + 1024  , L_SINK = L_B2ALL + 12288  ;
static_assert(L_SINK + 128 <= LDS_BYTES && L_B2ALL >= MISC_OFF + 128, "bias tables sit between the LDS control words and the end of the allocation");
static_assert(L_END <= RING_BYTES, "attention LDS map");
struct Soft { float m, l; f32x16 y[4]; };

__device__ __forceinline__ void glds16(const void* g, LAS unsigned char* l) { __builtin_amdgcn_global_load_lds((const unsigned*)g, (LAS unsigned*)l, 16, 0, 0); }
__device__ __forceinline__ void stage_k(LAS unsigned char* dst, const bf16* g, int pitch_el, int wave, int lane) {
#pragma unroll
    for (int i = 0; i < 2; ++i) { const int r0 = 4 * (2 * wave + i), r = r0 + (lane >> 4), p = lane & 15, ch = p ^ (((r & 3) << 2) | ((r >> 2) & 3));
        glds16(g + (size_t)r * pitch_el + ch * 8, dst + r0 * 256); }
}
__device__ __forceinline__ void stage_v(LAS unsigned char* dst, const bf16* g, int pitch_el, int wave, int lane) {
#pragma unroll
    for (int i = 0; i < 2; ++i) { const int I = 2 * wave + i, key = 8 * (I >> 1) + ((lane >> 2) & 7), ch = 4 * (2 * (I & 1) + (lane >> 5)) + (lane & 3);
        glds16(g + (size_t)key * pitch_el + ch * 8, dst + I * 1024); }
}
__device__ __forceinline__ void qk64(f32x16& x0, f32x16& x1, LAS const unsigned char* kb, const bf16x8 (&qf)[8], int lane) {
    const int r = lane & 31, h = lane >> 5; const int xr = ((r & 3) << 2) | ((r >> 2) & 3);
    bf16x8 k0[8], k1[8];
#define QK_LD(ks) do { const int off_ = r * 256 + 16 * ((2 * (ks) + h) ^ xr); k0[ks] = *(LAS const bf16x8*)(kb + off_); k1[ks] = *(LAS const bf16x8*)(kb + off_ + 8192); } while (0)
#define QK_MM(ks) do { x0 = __builtin_amdgcn_mfma_f32_32x32x16_bf16(k0[ks], qf[ks], x0, 0, 0, 0); x1 = __builtin_amdgcn_mfma_f32_32x32x16_bf16(k1[ks], qf[ks], x1, 0, 0, 0); } while (0)
    QK_LD(0); QK_LD(1); QK_LD(2); QK_LD(3); QK_LD(4); QK_LD(5);
    __builtin_amdgcn_sched_barrier(0);
#pragma unroll
    for (int i = 0; i < 16; ++i) { x0[i] = 0.f; x1[i] = 0.f; }
    __builtin_amdgcn_s_setprio(1); QK_MM(0); QK_MM(1); __builtin_amdgcn_s_setprio(0);
    __builtin_amdgcn_sched_barrier(0);
    QK_LD(6); QK_LD(7);
    __builtin_amdgcn_sched_barrier(0);
    __builtin_amdgcn_s_setprio(1); QK_MM(2); QK_MM(3); QK_MM(4); QK_MM(5); QK_MM(6); QK_MM(7); __builtin_amdgcn_s_setprio(0);
#undef QK_LD
#undef QK_MM
}
__device__ __forceinline__ bf16x8 pack8(const f32x16& x, int s) {
    v4u w; w.x = pk_bf16(x[8 * s], x[8 * s + 1]); w.y = pk_bf16(x[8 * s + 2], x[8 * s + 3]); w.z = pk_bf16(x[8 * s + 4], x[8 * s + 5]); w.w = pk_bf16(x[8 * s + 6], x[8 * s + 7]);
    return __builtin_bit_cast(bf16x8, w);
}
__device__ __forceinline__ void pv64p(Soft& S, LAS const unsigned char* vb, const bf16x8 (&pf)[4], int lane) {
    const unsigned va = (unsigned)(uintptr_t)(vb + 8 * ((lane & 3) + 4 * ((lane >> 4) & 1) + 8 * ((lane >> 2) & 3) + 32 * (lane >> 5)));
    s16x4 vlo[16], vhi[16];
#define TRRD(dst, off) asm volatile("ds_read_b64_tr_b16 %0, %1 offset:%2" : "=&v"(dst) : "v"(va), "i"(off) : "memory")
#define PV_LD(q) do { TRRD(vlo[(q) * 4 + 0], ((q) * 8 + 0) * 512); TRRD(vhi[(q) * 4 + 0], ((q) * 8 + 4) * 512); TRRD(vlo[(q) * 4 + 1], ((q) * 8 + 1) * 512); TRRD(vhi[(q) * 4 + 1], ((q) * 8 + 5) * 512); \
                      TRRD(vlo[(q) * 4 + 2], ((q) * 8 + 2) * 512); TRRD(vhi[(q) * 4 + 2], ((q) * 8 + 6) * 512); TRRD(vlo[(q) * 4 + 3], ((q) * 8 + 3) * 512); TRRD(vhi[(q) * 4 + 3], ((q) * 8 + 7) * 512); } while (0)
#define PV_MM(q) do { __builtin_amdgcn_s_setprio(1); _Pragma("unroll") for (int c = 0; c < 4; ++c) { const bf16x8 vf_ = __builtin_shufflevector(vlo[(q) * 4 + c], vhi[(q) * 4 + c], 0, 1, 2, 3, 4, 5, 6, 7); \
        S.y[c] = __builtin_amdgcn_mfma_f32_32x32x16_bf16(vf_, pf[q], S.y[c], 0, 0, 0); } __builtin_amdgcn_s_setprio(0); } while (0)
#define PV_WAIT(n) do { asm volatile("s_waitcnt lgkmcnt(" #n ")" ::: "memory"); __builtin_amdgcn_sched_barrier(0); } while (0)
    __builtin_amdgcn_sched_barrier(0);
    PV_LD(0); PV_LD(1);
    PV_WAIT(8); PV_MM(0); __builtin_amdgcn_sched_barrier(0);
    PV_LD(2);
    PV_WAIT(8); PV_MM(1); __builtin_amdgcn_sched_barrier(0);
    PV_LD(3);
    PV_WAIT(8); PV_MM(2);
    PV_WAIT(0); PV_MM(3);
#undef TRRD
#undef PV_LD
#undef PV_MM
#undef PV_WAIT
}
__device__ __forceinline__ void pv64(Soft& S, LAS const unsigned char* vb, const f32x16& x0, const f32x16& x1, int lane) {
    bf16x8 pf[4];
    pf[0] = pack8(x0, 0); pf[1] = pack8(x0, 1); pf[2] = pack8(x1, 0); pf[3] = pack8(x1, 1);
    pv64p(S, vb, pf, lane);
}
constexpr float THR2 = 8.0f;
__device__ __forceinline__ void score64(Soft& S, bf16x8 (&pf)[4], const bf16x8 (&qf)[8], LAS const unsigned char* kb, int d0, bool rowflag, unsigned wlim, bool general, LAS const float* b2, int lane) {
    f32x16 x0, x1; qk64(x0, x1, kb, qf, lane);
    const int h = lane >> 5; const float NEG = -__builtin_inff(); float tmax = NEG;
    if (general) {
#pragma unroll
        for (int i = 0; i < 16; ++i) { const int d = d0 - ((i & 3) + 8 * (i >> 2) + 4 * h), e = d - 32;
            const float b0 = b2[min(max(d, 0), 127)], b1 = b2[min(max(e, 0), 127)];
            const float v0 = (rowflag && (unsigned)d < wlim) ? fmaf(x0[i], QK_C, b0) : NEG, v1 = (rowflag && (unsigned)e < wlim) ? fmaf(x1[i], QK_C, b1) : NEG;
            x0[i] = v0; x1[i] = v1; tmax = fmaxf(tmax, fmaxf(v0, v1)); }
    } else {
        float mr = fmaxf(x0[0], x1[0]);
#pragma unroll
        for (int i = 1; i < 16; ++i) mr = fmaxf(mr, fmaxf(x0[i], x1[i]));
        tmax = rowflag ? mr * QK_C : NEG;
    }
    tmax = xhalf_max(tmax);
    if (!__all(tmax - S.m <= THR2)) {
        const float mn = fmaxf(S.m, tmax), alpha = __builtin_amdgcn_exp2f(S.m - mn); S.m = mn; S.l *= alpha;
#pragma unroll
        for (int c = 0; c < 4; ++c)
#pragma unroll
            for (int i = 0; i < 16; ++i) S.y[c][i] *= alpha;
    }
    float rs = 0.f;
    if (general) {
        const float mn = S.m;
#pragma unroll
        for (int i = 0; i < 16; ++i) { x0[i] = __builtin_amdgcn_exp2f(x0[i] - mn); x1[i] = __builtin_amdgcn_exp2f(x1[i] - mn); rs += x0[i] + x1[i]; }
    } else {
        const float nm = rowflag ? -S.m : NEG;
#pragma unroll
        for (int i = 0; i < 16; ++i) { x0[i] = __builtin_amdgcn_exp2f(fmaf(x0[i], QK_C, nm)); x1[i] = __builtin_amdgcn_exp2f(fmaf(x1[i], QK_C, nm)); rs += x0[i] + x1[i]; }
    }
    rs = xhalf_sum(rs); S.l += rs;
    pf[0] = pack8(x0, 0); pf[1] = pack8(x0, 1); pf[2] = pack8(x1, 0); pf[3] = pack8(x1, 1);
}
template <int MODE>
__device__ __forceinline__ void run_tiles(Soft& S, const bf16x8 (&qf)[8], LAS unsigned char* lds, unsigned tilemask, unsigned wmask, const bf16* Kg, const bf16* Vg, int pitch_el,
                                          int tq, int wq0, unsigned rowmask, unsigned W, LAS const float* b2, int wave, int lane) {
    tilemask = __builtin_amdgcn_readfirstlane(tilemask); wmask = __builtin_amdgcn_readfirstlane(wmask);
    if (tilemask == 0u) return;
#define RT_STAGE(j, t) do { stage_k(lds + (j) * 32768, Kg + (size_t)(t) * 64 * pitch_el, pitch_el, wave, lane); stage_v(lds + (j) * 32768 + 16384, Vg + (size_t)(t) * 64 * pitch_el, pitch_el, wave, lane); } while (0)
    const bool late = wave >= 4;
    unsigned rem = tilemask; int cur = __builtin_ctz(rem); rem &= rem - 1u; int bi = 0, pbi = -1;
    bf16x8 pf[4];
    RT_STAGE(0, cur);
    for (;;) {
        asm volatile("s_waitcnt vmcnt(0)" ::: "memory");
        asm volatile("s_waitcnt lgkmcnt(0)" ::: "memory"); __builtin_amdgcn_s_barrier(); asm volatile("" ::: "memory");
        int nxt = -1;
        if (rem) { nxt = __builtin_ctz(rem); rem &= rem - 1u; const int bj = bi == 2 ? 0 : bi + 1; RT_STAGE(bj, nxt); }
        if (late && pbi >= 0) { pv64p(S, lds + pbi * 32768 + 16384, pf, lane); pbi = -1; }
        if ((wmask >> cur) & 1u) {
            const int d0 = tq - 64 * cur; bool general = (wq0 - 64 * cur - 63) < 113;
            bool rowflag = true; unsigned wlim = 0x80000000u;
            if (MODE == 0) { wlim = W; general = general || (wq0 + 31 - 64 * cur) >= (int)W; } else if (MODE == 1) rowflag = (rowmask >> cur) & 1u; else rowflag = (rowmask >> (cur >> 2)) & 1u;
            score64(S, pf, qf, lds + bi * 32768, d0, rowflag, wlim, general, b2, lane);
            if (late) pbi = bi; else pv64p(S, lds + bi * 32768 + 16384, pf, lane);
        }
        if (nxt < 0) break;
        cur = nxt; bi = bi == 2 ? 0 : bi + 1;
    }
    if (late && pbi >= 0) pv64p(S, lds + pbi * 32768 + 16384, pf, lane);
    asm volatile("s_waitcnt lgkmcnt(0)" ::: "memory"); __builtin_amdgcn_s_barrier(); asm volatile("" ::: "memory");
#undef RT_STAGE
}
__device__ __forceinline__ int t5_bucket(int n) {
    if (n < 16) return n;
    int b = 16;
    b += (n >= 19) + (n >= 21) + (n >= 24) + (n >= 27) + (n >= 31) + (n >= 35) + (n >= 40) + (n >= 46) + (n >= 52) + (n >= 59) + (n >= 67) + (n >= 77) + (n >= 87) + (n >= 99) + (n >= 113);
    return b;
}
__device__ __forceinline__ void fill_b2all(LAS unsigned char* lds, const float* rel_bias, const float* sinks  , int tid) {
    LAS float* T = (LAS float*)(lds + L_B2ALL);
#pragma unroll
    for (int e = 0; e < 6; ++e) { const int i = tid + 512 * e, col = i >> 7, idx = i & 127; T[i] = (rel_bias[t5_bucket(idx) * 24 + col] - rel_bias[31 * 24 + col]) * LOG2E; }
    if (tid < 8 * DEPTH) ((LAS float*)(lds + L_SINK))[tid] = (sinks[tid] - rel_bias[31 * 24 + 8 + (tid & 7)]) * LOG2E;
}
__device__ __forceinline__ void load_q(bf16x8 (&qf)[8], const bf16* Q, int token, int head, int h) {
#pragma unroll
    for (int ks = 0; ks < 8; ++ks) qf[ks] = *(const bf16x8*)(Q + (size_t)token * 1024 + head * 128 + 16 * ks + 8 * h);
}
__device__ __forceinline__ void soft_init(Soft& S) { S.m = -1e30f; S.l = 0.f;
#pragma unroll
    for (int c = 0; c < 4; ++c)
#pragma unroll
        for (int i = 0; i < 16; ++i) S.y[c][i] = 0.f; }
__device__ __forceinline__ unsigned wave_or32(unsigned v) {
#pragma unroll
    for (int o = 1; o < 32; o <<= 1) v |= (unsigned)__shfl_xor((int)v, o);
    return v;
}
__device__ __forceinline__ unsigned block_or(LAS unsigned char* lds, unsigned wv, int wave, int lane) {
    LAS unsigned* WM = (LAS unsigned*)(lds + L_WM);
    if (lane == 0) WM[wave] = wv;
    __syncthreads();
    unsigned t = 0;
#pragma unroll
    for (int i = 0; i < 8; ++i) t |= WM[i];
    __syncthreads();
    return t;
}
struct Ptrs { const bf16* Q; const bf16* KV; const float* AG; const bf16* KC; const bf16* VC; const bf16* KMEAN; bf16* O; unsigned char* O8; int layer, pad; };

template <bool ADD>
__device__ __forceinline__ void store_o(const Soft& S, float sc, bf16* O, int token, int head, int h) {
    bf16* op = O + (size_t)token * 1024 + head * 128;
#pragma unroll
    for (int c = 0; c < 4; ++c)
#pragma unroll
        for (int ip = 0; ip < 2; ++ip) { v2u pk[2];
#pragma unroll
            for (int e = 0; e < 2; ++e) { const int ii = 2 * ip + e;
                float a0 = S.y[c][4 * ii] * sc, a1 = S.y[c][4 * ii + 1] * sc, a2 = S.y[c][4 * ii + 2] * sc, a3 = S.y[c][4 * ii + 3] * sc;
                if (ADD) { const v2u w = *(const v2u*)(op + 32 * c + 8 * ii + 4 * h); a0 += bf_lo(w.x); a1 += bf_hi(w.x); a2 += bf_lo(w.y); a3 += bf_hi(w.y); }
                pk[e].x = pk_bf16(a0, a1); pk[e].y = pk_bf16(a2, a3); }
            auto rx = __builtin_amdgcn_permlane32_swap(pk[0].x, pk[1].x, false, false); auto ry = __builtin_amdgcn_permlane32_swap(pk[0].y, pk[1].y, false, false);
            const v4u o = {rx[0], ry[0], rx[1], ry[1]};
            *(v4u*)(op + 32 * c + 16 * ip + 8 * h) = o; }
}

template <bool ADD>
__device__ __forceinline__ void store_o8(const Soft& S, float sc, const bf16* O, unsigned char* O8, int token, int head, int h) {
    const bf16* op = O + (size_t)token * 1024 + head * 128; unsigned char* op8 = O8 + (size_t)token * 1024 + head * 128; const float sc16 = sc * 16.0f;
#pragma unroll
    for (int c = 0; c < 4; ++c)
#pragma unroll
        for (int ip = 0; ip < 2; ++ip) { unsigned pk[2];
#pragma unroll
            for (int e = 0; e < 2; ++e) { const int ii = 2 * ip + e;
                float a0 = S.y[c][4 * ii] * sc16, a1 = S.y[c][4 * ii + 1] * sc16, a2 = S.y[c][4 * ii + 2] * sc16, a3 = S.y[c][4 * ii + 3] * sc16;
                if (ADD) { const v2u w = *(const v2u*)(op + 32 * c + 8 * ii + 4 * h); a0 = fmaf(bf_lo(w.x), 16.0f, a0); a1 = fmaf(bf_hi(w.x), 16.0f, a1); a2 = fmaf(bf_lo(w.y), 16.0f, a2); a3 = fmaf(bf_hi(w.y), 16.0f, a3); }
                int w8 = __builtin_amdgcn_cvt_pk_fp8_f32(a0, a1, 0, false); w8 = __builtin_amdgcn_cvt_pk_fp8_f32(a2, a3, w8, true); pk[e] = (unsigned)w8; }
            auto rx = __builtin_amdgcn_permlane32_swap(pk[0], pk[1], false, false);
            const v2u o = {rx[0], rx[1]};
            *(v2u*)(op8 + 32 * c + 16 * ip + 8 * h) = o; }
}

__device__ __forceinline__ void unit_A(LAS unsigned char* lds, const Ptrs& P, int b, int kvh, int qt, int tid, int wave, int lane) {
    const int g = wave >> 1, qh = wave & 1, n = lane & 31, h = lane >> 5;
    const int wq0 = 64 * qt + 32 * qh, tq = wq0 + n, token = b * SEQ + tq, head = kvh * 4 + g;
    bf16x8 qf[8]; load_q(qf, P.Q, token, head, h);
    { const bf16* kc = P.KC + (size_t)(b * 2 + kvh) * 128 * 128; const bf16* vc = P.VC + (size_t)(b * 2 + kvh) * 128 * 128;
      stage_k(lds + L_K0, kc, 128, wave, lane); stage_k(lds + L_K0 + L_ST, kc + 64 * 128, 128, wave, lane);
      stage_v(lds + L_V0, vc, 128, wave, lane); stage_v(lds + L_V0 + L_ST, vc + 64 * 128, 128, wave, lane); }
    const float g0 = P.AG[(size_t)token * 24 + head * 3], g1 = P.AG[(size_t)token * 24 + head * 3 + 1], g2 = P.AG[(size_t)token * 24 + head * 3 + 2];
    VM_WAIT(); __syncthreads();
    LAS const float* b2 = (LAS const float*)(lds + L_B2ALL) + (kvh * 4 + g) * 128;
    Soft S; soft_init(S);
    {
        f32x16 x[4];
        qk64(x[0], x[1], lds + L_K0, qf, lane); qk64(x[2], x[3], lds + L_K0 + L_ST, qf, lane);
        const float NEG = -__builtin_inff(); float tmax = NEG; const int dbase = tq - 31 - 64 * h;
#pragma unroll
        for (int s4 = 0; s4 < 4; ++s4) {
            const int dmin = wq0 - 512 * s4 - 527, dmax = wq0 + 31 - 512 * s4 - 31;
            if (dmax < 0) {
#pragma unroll
                for (int i = 0; i < 16; ++i) x[s4][i] = NEG;
            } else if (dmin >= 113) {
#pragma unroll
                for (int i = 0; i < 16; ++i) { const int c0 = 32 * s4 + (i & 3) + 8 * (i >> 2); float v = x[s4][i] * QK_C; if (c0 + 4 == 127) v = (h == 0) ? v : NEG; x[s4][i] = v; tmax = fmaxf(tmax, v); }
            } else {
#pragma unroll
                for (int i = 0; i < 16; ++i) { const int c0 = 32 * s4 + (i & 3) + 8 * (i >> 2), d = dbase - 16 * c0;
                    const float bb = b2[min(max(d, 0), 127)]; float v = fmaf(x[s4][i], QK_C, bb);
                    bool ok = d >= 0; if (c0 + 4 == 127) ok = ok && (h == 0);
                    v = ok ? v : NEG; x[s4][i] = v; tmax = fmaxf(tmax, v); }
            }
        }
        tmax = xhalf_max(tmax);
        const float ms = (tmax == NEG) ? 0.f : tmax; float rs = 0.f;
#pragma unroll
        for (int s4 = 0; s4 < 4; ++s4)
#pragma unroll
            for (int i = 0; i < 16; ++i) { x[s4][i] = __builtin_amdgcn_exp2f(x[s4][i] - ms); rs += x[s4][i]; }
        rs = xhalf_sum(rs);
        const float inv = rs > 0.f ? 1.0f / rs : 0.f;
#pragma unroll
        for (int s4 = 0; s4 < 4; ++s4)
#pragma unroll
            for (int i = 0; i < 16; ++i) x[s4][i] *= inv;
        LAS float* IMP = (LAS float*)(lds + L_IMP); const int ql = 32 * qh + n; float prev_s3 = 0.f;
#pragma unroll
        for (int s4 = 0; s4 < 4; ++s4)
#pragma unroll
            for (int ii = 0; ii < 4; ++ii) { const float s3 = x[s4][4 * ii + 3], a = 2.f * (x[s4][4 * ii] + x[s4][4 * ii + 1] + x[s4][4 * ii + 2]) + s3;
                const float send = h ? prev_s3 : s3, recv = __shfl_xor(send, 32);
                IMP[(g * 64 + ql) * 32 + 8 * s4 + 2 * ii + h] = a + recv; prev_s3 = s3; }
        bf16x8 pfa[4], pfb[4];
        pfa[0] = pack8(x[0], 0); pfa[1] = pack8(x[0], 1); pfa[2] = pack8(x[1], 0); pfa[3] = pack8(x[1], 1);
        pfb[0] = pack8(x[2], 0); pfb[1] = pack8(x[2], 1); pfb[2] = pack8(x[3], 0); pfb[3] = pack8(x[3], 1);
        __builtin_amdgcn_sched_barrier(0);
        pv64p(S, lds + L_V0, pfa, lane); pv64p(S, lds + L_V0 + L_ST, pfb, lane);
        store_o<false>(S, g0, P.O, token, head, h);
    }
    __syncthreads();
    unsigned selmask;
    {
        LAS const float* IMP = (LAS const float*)(lds + L_IMP); LAS float* IMPS = (LAS float*)(lds + L_IMPS);
#pragma unroll
        for (int e = 0; e < 4; ++e) { const int idx = tid + 512 * e; IMPS[(idx >> 5) * 33 + (idx & 31)] = (IMP[idx] + IMP[2048 + idx]) + (IMP[4096 + idx] + IMP[6144 + idx]); }
        __syncthreads();
        const int q = tid >> 3, sub = tid & 7, cur = qt; const int quota = 16 - (cur >= 2 ? 3 : cur + 1); unsigned bits = 0u;
        {
            float v4[4]; int rk[4] = {0, 0, 0, 0};
#pragma unroll
            for (int jj = 0; jj < 4; ++jj) v4[jj] = IMPS[q * 33 + sub * 4 + jj];
#pragma clang loop unroll_count(4) vectorize(disable)
            for (int j2 = 1; j2 <= cur - 2; ++j2) { const float v2 = IMPS[q * 33 + j2];
#pragma unroll
                for (int jj = 0; jj < 4; ++jj) rk[jj] += (v2 > v4[jj] || (v2 == v4[jj] && j2 < sub * 4 + jj)) ? 1 : 0; }
#pragma unroll
            for (int jj = 0; jj < 4; ++jj) { const int j = sub * 4 + jj;
                if (j <= cur && (j == 0 || j >= cur - 1 || rk[jj] < quota)) bits |= 1u << j; }
        }
        bits |= (unsigned)__shfl_xor((int)bits, 1); bits |= (unsigned)__shfl_xor((int)bits, 2); bits |= (unsigned)__shfl_xor((int)bits, 4);
        LAS unsigned* SEL = (LAS unsigned*)(lds + L_SEL);
        if (sub == 0) SEL[q] = bits;
        __syncthreads();
        selmask = SEL[32 * qh + n];
    }
    const unsigned wm_sel = wave_or32(selmask);
    const unsigned tm_sel = block_or(lds, wm_sel, wave, lane);
    soft_init(S);
    run_tiles<1>(S, qf, lds, tm_sel, wm_sel, P.KV + (size_t)2 * pg8::TOK * 256 + (size_t)b * SEQ * 256 + kvh * 128, P.KV + (size_t)3 * pg8::TOK * 256 + (size_t)b * SEQ * 256 + kvh * 128, 256, tq, wq0, selmask, 0u, b2, wave, lane);
    store_o<true>(S, S.l > 0.f ? g1 / S.l : 0.f, P.O, token, head, h);
    soft_init(S);
    { const int lo = qt >= 8 ? qt - 8 : 0; const unsigned tm = (qt == 31 ? 0xffffffffu : ((2u << qt) - 1u)) & ~((1u << lo) - 1u);
      run_tiles<0>(S, qf, lds, tm, tm, P.KV + (size_t)4 * pg8::TOK * 256 + (size_t)b * SEQ * 256 + kvh * 128, P.KV + (size_t)5 * pg8::TOK * 256 + (size_t)b * SEQ * 256 + kvh * 128, 256, tq, wq0, 0u, 512u, b2, wave, lane); }
    store_o8<true>(S, S.l > 0.f ? g2 / S.l : 0.f, P.O, P.O8, token, head, h);
}
__device__ __forceinline__ void unit_B(LAS unsigned char* lds, const Ptrs& P, int b, int kvh, int qt, int tid, int wave, int lane) {
    const int g = wave >> 1, qh = wave & 1, n = lane & 31, h = lane >> 5;
    const int wq0 = 64 * qt + 32 * qh, tq = wq0 + n, token = b * SEQ + tq, head = kvh * 4 + g;
    bf16x8 qf[8]; load_q(qf, P.Q + (size_t)pg8::TOK * 1024, token, head, h);
    const float sink2 = ((LAS const float*)(lds + L_SINK))[P.layer * 8 + head];
    LAS const float* b2 = (LAS const float*)(lds + L_B2ALL) + (8 + head) * 128;
    Soft S; soft_init(S);
    const int lo = qt >= 2 ? qt - 2 : 0; const unsigned tm = (qt == 31 ? 0xffffffffu : ((2u << qt) - 1u)) & ~((1u << lo) - 1u);
    run_tiles<0>(S, qf, lds, tm, tm, P.KV + (size_t)6 * pg8::TOK * 256 + (size_t)b * SEQ * 256 + kvh * 128, P.KV + (size_t)7 * pg8::TOK * 256 + (size_t)b * SEQ * 256 + kvh * 128, 256, tq, wq0, 0u, 128u, b2, wave, lane);
    const float den = S.l + __builtin_amdgcn_exp2f(sink2 - S.m);
    store_o8<false>(S, 1.0f / fmaxf(den, 1e-30f), nullptr, P.O8 + (size_t)pg8::TOK * 1024, token, head, h);
}
__device__ __forceinline__ void unit_C(LAS unsigned char* lds, const Ptrs& P, int b, int kvh, int qt, int tid, int wave, int lane) {
    const int g = wave >> 1, qh = wave & 1, n = lane & 31, h = lane >> 5;
    const int wq0 = 64 * qt + 32 * qh, tq = wq0 + n, token = b * SEQ + tq, head = kvh * 4 + g;
    bf16x8 qf[8]; load_q(qf, P.Q + (size_t)2 * pg8::TOK * 1024, token, head, h);
    if (tid < 128) { const int r = tid >> 4, ch = tid & 15; const v4u v = *(const v4u*)(P.KMEAN + (size_t)((b * 2 + kvh) * 8 + r) * 128 + ch * 8);
        *(LAS v4u*)(lds + L_K0 + r * 256 + 16 * (ch ^ (((r & 3) << 2) | ((r >> 2) & 3)))) = v; }
    __syncthreads();
    LAS const float* b2 = (LAS const float*)(lds + L_B2ALL) + (16 + head) * 128;
    const int qblk = qt >> 2; unsigned bm = 1u << qblk;
    {
        f32x16 x0, x1; qk64(x0, x1, lds + L_K0, qf, lane);
        float gv[8];
#pragma unroll
        for (int e = 0; e < 4; ++e) { const float own = x0[e], oth = __shfl_xor(own, 32); gv[e] = h ? oth : own; gv[4 + e] = h ? own : oth; }
#pragma unroll
        for (int k = 0; k < 8; ++k) { int rank = 0;
#pragma unroll
            for (int k2 = 0; k2 < 8; ++k2) if (k2 != k) rank += (k2 < qblk && (gv[k2] > gv[k] || (gv[k2] == gv[k] && k2 < k))) ? 1 : 0;
            if (k < qblk && rank < 3) bm |= 1u << k; }
    }
    const unsigned wbm = wave_or32(bm); unsigned wm = 0u;
#pragma unroll
    for (int k = 0; k < 8; ++k) if ((wbm >> k) & 1u) wm |= 0xfu << (4 * k);
    wm &= (qt == 31 ? 0xffffffffu : ((2u << qt) - 1u));
    const unsigned tm = block_or(lds, wm, wave, lane);
    Soft S; soft_init(S);
    run_tiles<2>(S, qf, lds, tm, wm, P.KV + (size_t)8 * pg8::TOK * 256 + (size_t)b * SEQ * 256 + kvh * 128, P.KV + (size_t)9 * pg8::TOK * 256 + (size_t)b * SEQ * 256 + kvh * 128, 256, tq, wq0, bm, 0u, b2, wave, lane);
    store_o8<false>(S, S.l > 0.f ? 1.0f / S.l : 0.f, nullptr, P.O8 + (size_t)2 * pg8::TOK * 1024, token, head, h);
}
template <int TYPES>
__device__ __forceinline__ void attn_phase(LAS unsigned char* lds, const Ptrs& P, unsigned* head_word, int first, int count, int tid, int wave, int lane) {
    for (;;) {
        if (tid == 0) *(LAS int*)(lds + L_SLOT) = (int)__hip_atomic_fetch_add(head_word, 1u, __ATOMIC_RELAXED, __HIP_MEMORY_SCOPE_AGENT);
        __syncthreads();
        const int pop = __builtin_amdgcn_readfirstlane(*(LAS int*)(lds + L_SLOT));
        __syncthreads();
        if (pop >= count) break;
        const int slot = first + pop, typ = slot >> 8, r = slot & 255, qt = 31 - (r >> 3), b = (r & 7) >> 1, kvh = r & 1;
        int tid_u = tid; asm volatile("" : "+v"(tid_u));
        const int lane_u = tid_u & 63, wave_u = __builtin_amdgcn_readfirstlane(tid_u >> 6);
        if ((TYPES & 1) && typ == 0) unit_A(lds, P, b, kvh, qt, tid_u, wave_u, lane_u);
        else if ((TYPES & 2) && typ == 1) unit_C(lds, P, b, kvh, qt, tid_u, wave_u, lane_u);
        else if ((TYPES & 4) && typ == 2) unit_B(lds, P, b, kvh, qt, tid_u, wave_u, lane_u);
        __syncthreads();
    }
}
}

__device__ __forceinline__ float gelu_tanh(float x) { const float u = 0.7978845608028654f * (x + 0.044715f * x * x * x); const float t = 1.0f - 2.0f / (1.0f + __expf(2.0f * u)); return 0.5f * x * (1.0f + t); }
__device__ __forceinline__ void compress2_unit(LAS unsigned char* lds, const float* part, const bf16* W2t, const float* cbp, bf16* outc, int kv, int rg, int tid, int wave, int lane) {
    typedef float f32x4_ __attribute__((ext_vector_type(4)));
    LAS float* cb = (LAS float*)(lds + att::L_IMP);
    LAS bf16* hid = (LAS bf16*)(lds + att::L_IMP + 1024);
    if (tid < 256) cb[tid] = cbp[tid];
    __syncthreads();
    { const int row = tid >> 5, c8 = (tid & 31) * 8; f32x4_ a0 = {0.f, 0.f, 0.f, 0.f}, a1 = {0.f, 0.f, 0.f, 0.f};
#pragma unroll
      for (int kc = 0; kc < 8; ++kc) { const float* p = part + ((size_t)(kc * 2 + kv) * 1024 + rg * 16 + row) * 256 + c8; a0 += *(const f32x4_*)p; a1 += *(const f32x4_*)(p + 4); }
      v4u w; w.x = pk_bf16(gelu_tanh(a0[0] + cb[c8]), gelu_tanh(a0[1] + cb[c8 + 1])); w.y = pk_bf16(gelu_tanh(a0[2] + cb[c8 + 2]), gelu_tanh(a0[3] + cb[c8 + 3]));
      w.z = pk_bf16(gelu_tanh(a1[0] + cb[c8 + 4]), gelu_tanh(a1[1] + cb[c8 + 5])); w.w = pk_bf16(gelu_tanh(a1[2] + cb[c8 + 6]), gelu_tanh(a1[3] + cb[c8 + 7]));
      *(LAS v4u*)(hid + row * 264 + c8) = w; }
    __syncthreads();
    const int fr = lane & 15, fq = lane >> 4;
    f32x4_ acc2 = {0.f, 0.f, 0.f, 0.f};
    const bf16* wp = W2t + (size_t)(16 * wave + fr) * 256 + 8 * fq;
#pragma unroll
    for (int ks = 0; ks < 8; ++ks) { const bf16x8 a = *(LAS const bf16x8*)(hid + fr * 264 + 32 * ks + 8 * fq), bb = *(const bf16x8*)(wp + 32 * ks);
        acc2 = __builtin_amdgcn_mfma_f32_16x16x32_bf16(a, bb, acc2, 0, 0, 0); }
#pragma unroll
    for (int e = 0; e < 4; ++e) { const int r = rg * 16 + 4 * fq + e; const float v = ((r & 127) == 127) ? 0.f : acc2[e];
        outc[(size_t)r * 128 + 16 * wave + fr] = (bf16)(pk_bf16(v, 0.f) & 0xffffu); }
    __syncthreads();
}
__device__ __forceinline__ void kmean_unit(LAS unsigned char* lds, const bf16* CK, bf16* KMEAN, int u, int tid) {
    const int b = u >> 4, kvh = (u >> 3) & 1, blk = u & 7, d = tid & 127, part = tid >> 7;
    const bf16* p = CK + ((size_t)(b * SEQ + blk * 256) * 256) + kvh * 128 + d; float s = 0.f;
    for (int i = part; i < 256; i += 4) s += __builtin_bit_cast(float, (unsigned)p[(size_t)i * 256] << 16);
    LAS float* pp = (LAS float*)(lds + att::L_PART);
    pp[part * 128 + d] = s;
    __syncthreads();
    if (tid < 128) { const float m = ((pp[tid] + pp[128 + tid]) + (pp[256 + tid] + pp[384 + tid])) * (1.0f / 256.0f);
        KMEAN[(size_t)((b * 2 + kvh) * 8 + blk) * 128 + tid] = (bf16)(pk_bf16(m, 0.f) & 0xffffu); }
    __syncthreads();
}

struct Args { const float* in[14]; float* out; unsigned char* ws; int ph_lo, ph_hi, use_bar, pad; };
template <class T> __device__ __forceinline__ T* as_global(T* p) { return (T*)(GAS T*)p; }
constexpr int N_PHASES = 2 + 8 * DEPTH;

__global__ void __launch_bounds__(NWAVES * 64, 2) trunk_fwd(Args args) {
    extern __shared__ __attribute__((aligned(16))) unsigned char lds_raw[];
    LAS unsigned char* lds = (LAS unsigned char*)lds_raw;
    {   const int t0 = threadIdx.x;
        for (int u = t0; u < (LDS_BYTES - LDSCTL_OFF) / 4; u += NWAVES * 64) ((LAS unsigned*)(lds + LDSCTL_OFF))[u] = 0u;
        __syncthreads();
        att::fill_b2all(lds, as_global(args.in[13]), as_global(args.in[5]), t0);
        __syncthreads(); }
    XcdBarrier bar; bar.bar = (unsigned*)(args.ws + WS_CTL) + CW_BAR; bar.x = 0; bar.st = nullptr;
    if (args.use_bar) bar = xcd_barrier_post((unsigned*)(args.ws + WS_CTL) + CW_BAR, (volatile LAS unsigned*)(lds + MISC_OFF) + 8);
    const int lo = args.ph_lo, hi = args.ph_hi;
#ifndef PHMASK
#define PHMASK 0x3ff
#endif
#ifndef REP_PRO
#define REP_PRO 1
#define REP_PROJ 1
#define REP_PREP 1
#define REP_ATTN 1
#define REP_BR 1
#define REP_NORM 1
#define REP_MI 1
#endif
#define IN(k) (lo <= (k) && (k) < hi)
#define SEAM(k) do { if (IN(k) && IN((k) + 1)) xcd_barrier(bar); } while (0)
#define PHASE_LOCALS() int tid = threadIdx.x; asm volatile("" : "+v"(tid)); const int lane = tid & 63, wave = __builtin_amdgcn_readfirstlane(tid >> 6); \
    GAS unsigned char* wsg_ = (GAS unsigned char*)args.ws; asm volatile("" : "+s"(wsg_)); unsigned char* ws = (unsigned char*)wsg_;     \
    const int G = gridDim.x, bx = blockIdx.x, vcu = (G % 8 == 0) ? (bx % 8) * (G / 8) + bx / 8 : bx, gw = vcu * NWAVES + wave, NGW = G * NWAVES; \
    (void)lane; (void)gw; (void)NGW; (void)vcu; (void)bx

    for (int rep = 0; rep < REP_PRO; ++rep) if ((PHMASK & 1) && IN(0)) {
        PHASE_LOCALS();
        const float* x_in = as_global(args.in[0]); const float* w_in = as_global(args.in[1]); const float* cmp_pos = as_global(args.in[2]); const float* cmp_w1 = as_global(args.in[3]); const float* cmp_w2 = as_global(args.in[4]);
        const float* w_branch = as_global(args.in[6]); const float* w_out = as_global(args.in[7]); const float* w_mlp_in = as_global(args.in[8]); const float* w_mlp_out = as_global(args.in[9]); const float* norm_mix = as_global(args.in[10]);
        bf16* Wmi_t = (bf16*)(ws + WS_WMI); bf16* Wmo_t = (bf16*)(ws + WS_WMO);
        bf16* CW1 = (bf16*)(ws + WS_CW1); bf16* CW2 = (bf16*)(ws + WS_CW2); float* CBP = (float*)(ws + WS_CBP);
        LAS float* scr = (LAS float*)(lds + RING_OFF + wave * 16384);
        constexpr int I_IN = 32 * 369, I_BR = 16 * 64, I_OUT = 32 * 64, I_MI = 32 * 256, I_MO = 128 * 64, I_C1 = 64 * 8, I_C2 = 4 * 4;
        constexpr int I_LAYER = I_IN + 3 * I_BR + I_OUT + I_MI + I_MO + 2 * I_C1 + 2 * I_C2;
        for (int it = gw; it < DEPTH * I_LAYER; it += NGW) {
            const int l = it / I_LAYER; int r = it % I_LAYER;
            if (r < I_IN) { p0_transpose_item<1>(w_in + (size_t)l * DM * DIN, DM, DIN, nullptr, scr, r, lane, nullptr, nullptr, ws + WS_WIN8 + (size_t)l * DINP * DM); continue; } r -= I_IN;
            if (r < 3 * I_BR) { const int m = r / I_BR; p0_transpose_item<3>(w_branch + (size_t)(l * 3 + m) * 1024 * 2048, 1024, 2048, nullptr, scr, r % I_BR, lane, nullptr, nullptr, ws + WS_WBR + (size_t)(l * 3 + m) * 2048 * 1024); continue; } r -= 3 * I_BR;
            if (r < I_OUT) { p0_transpose_item<3>(w_out + (size_t)l * 2048 * 2048, 2048, 2048, nullptr, scr, r, lane, nullptr, nullptr, ws + WS_WOUT + (size_t)l * 2048 * 2048); continue; } r -= I_OUT;
            if (r < I_MI) { p0_transpose_item<0>(w_mlp_in + (size_t)l * 2048 * 8192, 2048, 8192, Wmi_t + (size_t)l * 8192 * 2048, scr, r, lane, nullptr, nullptr); continue; } r -= I_MI;
            if (r < I_MO) { p0_transpose_item<0>(w_mlp_out + (size_t)l * 8192 * 2048, 8192, 2048, Wmo_t + (size_t)l * 2048 * 8192, scr, r, lane, nullptr, nullptr); continue; } r -= I_MO;
            if (r < 2 * I_C1) { const int kv = r / I_C1; p0_transpose_item<2>(cmp_w1 + (size_t)(l * 2 + kv) * 4096 * 256, 4096, 256, CW1 + (size_t)(l * 2 + kv) * 256 * 4096, scr, r % I_C1, lane, cmp_pos + (size_t)(l * 2 + kv) * 4096, CBP + (size_t)(l * 2 + kv) * 64 * 256); continue; } r -= 2 * I_C1;
            { const int kv = r / I_C2; p0_transpose_item<0>(cmp_w2 + (size_t)(l * 2 + kv) * 256 * 128, 256, 128, CW2 + (size_t)(l * 2 + kv) * 128 * 256, scr, r % I_C2, lane, nullptr, nullptr); }
        }
        for (int rr = gw; rr < DEPTH * 232; rr += NGW) { const int l = rr / 232, row = 11800 + rr % 232; GAS v4u* o = (GAS v4u*)(ws + WS_WIN8 + ((size_t)l * DINP + row) * DM);
#pragma unroll
            for (int j = 0; j < 2; ++j) o[lane + 64 * j] = (v4u){0u, 0u, 0u, 0u}; }
        for (int m = gw; m < pg8::TOK; m += NGW) rms_row<false, true>(x_in + (size_t)m * DM, norm_mix, nullptr, nullptr, lane, (unsigned*)(ws + WS_H8 + (size_t)m * DM));
    }
    SEAM(0);

    for (int l = 0; l < DEPTH; ++l) {
        const int pb = 1 + 8 * l;
        for (int rep = 0; rep < REP_PROJ; ++rep) if ((PHMASK & 2) && IN(pb + 0)) {
            PHASE_LOCALS();
            pg8::Gemm g{(const bf16*)(ws + WS_H8), (const bf16*)(ws + WS_WIN8 + (size_t)l * DINP * DM), pg8::TOK, DINP, DM / 2, DM / 2, DM / 2}; pg8::StaticOrder S; S.init(pg8::TOK, DINP, G, bx);
            pg8::EpiProj E{(bf16*)(ws + WS_Q), (bf16*)(ws + WS_KV), ws + WS_MG, (float*)(ws + WS_AG)};
            pg8::gemm_phase<pg8::EpiProj, pg8::StaticOrder, true, true, true>(lds + RING_OFF, g, S, E);
            if (bx == G - 1) {
                const float* cp = (const float*)(ws + WS_CBP) + (size_t)l * 2 * 64 * 256; float* cs = (float*)(ws + WS_CBP + 524288) + (size_t)l * 2 * 256;
                const int kv = tid >> 8, col = tid & 255; float sum = 0.f;
                for (int kb = 0; kb < 64; ++kb) sum += cp[(size_t)(kv * 64 + kb) * 256 + col];
                cs[kv * 256 + col] = sum; }
        }
        SEAM(pb + 0);
        for (int rep = 0; rep < REP_PREP; ++rep) if ((PHMASK & 4) && IN(pb + 1)) {
            PHASE_LOCALS();
            if (bx < 64) {
                pg8::Gemm g{(const bf16*)(ws + WS_KV), (const bf16*)(ws + WS_CW1) + (size_t)l * 2 * 256 * 4096, 2048, 512, 512, 2048, 4096}; pg8::CmpOrder S{bx};
                pg8::EpiPart E{(float*)(ws + WS_PART)};
                pg8::gemm_phase<pg8::EpiPart, pg8::CmpOrder, false, true>(lds + RING_OFF, g, S, E);
            } else {
                if (bx < 128) kmean_unit(lds, (const bf16*)(ws + WS_KV) + (size_t)8 * pg8::TOK * 256, (bf16*)(ws + WS_KC + 524288), bx - 64, tid);
                att::Ptrs P{(const bf16*)(ws + WS_Q), (const bf16*)(ws + WS_KV), (const float*)(ws + WS_AG), (const bf16*)(ws + WS_KC), (const bf16*)(ws + WS_KC + 262144), (const bf16*)(ws + WS_KC + 524288),
                            (bf16*)(ws + WS_O), ws + WS_O8, l, 0};
                att::attn_phase<4>(lds, P, (unsigned*)(ws + WS_CTL) + CW_WQ + 64 * (l + 16 + 4 * rep), 512, 256, tid, wave, lane); }
        }
        SEAM(pb + 1);
        for (int rep = 0; rep < REP_PREP; ++rep) if ((PHMASK & 4) && IN(pb + 2)) {
            PHASE_LOCALS();
            for (int u = vcu; u < 128; u += G) { const int kv = u >> 6, rg = u & 63;
                compress2_unit(lds, (const float*)(ws + WS_PART), (const bf16*)(ws + WS_CW2) + (size_t)(l * 2 + kv) * 128 * 256, (const float*)(ws + WS_CBP + 524288) + (size_t)(l * 2 + kv) * 256,
                               (bf16*)(ws + WS_KC + (kv ? 262144 : 0)), kv, rg, tid, wave, lane); }
        }
        SEAM(pb + 2);
        for (int rep = 0; rep < REP_ATTN; ++rep) if ((PHMASK & 8) && IN(pb + 3)) {
            PHASE_LOCALS();
            att::Ptrs P{(const bf16*)(ws + WS_Q), (const bf16*)(ws + WS_KV), (const float*)(ws + WS_AG), (const bf16*)(ws + WS_KC), (const bf16*)(ws + WS_KC + 262144), (const bf16*)(ws + WS_KC + 524288),
                        (bf16*)(ws + WS_O), ws + WS_O8, l, 0};
            att::attn_phase<3>(lds, P, (unsigned*)(ws + WS_CTL) + CW_WQ + 64 * (l + 4 * rep), 0, 512, tid, wave, lane);
        }
        SEAM(pb + 3);
        for (int rep = 0; rep < REP_BR; ++rep) if ((PHMASK & 16) && IN(pb + 4)) {
            PHASE_LOCALS();
            pg8::Gemm g{(const bf16*)(ws + WS_O8), (const bf16*)(ws + WS_WBR + (size_t)l * 3 * 2048 * 1024), 3 * pg8::TOK, 3 * 2048, 512, 512, 512}; pg8::BranchOrder S; S.S.init(pg8::TOK, 2048, G, bx);
            pg8::EpiBranch E{(const unsigned char*)(ws + WS_MG), ws + WS_Z};
            pg8::gemm_phase<pg8::EpiBranch, pg8::BranchOrder, true, true, true>(lds + RING_OFF, g, S, E);
        }
        SEAM(pb + 4);
        if ((PHMASK & 32) && IN(pb + 5)) {
            PHASE_LOCALS();
            pg8::Gemm g{(const bf16*)(ws + WS_Z), (const bf16*)(ws + WS_WOUT + (size_t)l * 2048 * 2048), pg8::TOK, 2048, 1024, 1024, 1024}; pg8::StaticOrder S; S.init(pg8::TOK, 2048, G, bx);
            pg8::EpiResidN E{(l == 0) ? as_global(args.in[0]) : (const float*)(ws + WS_X), (float*)(ws + WS_X), as_global(args.in[11]) + l * DM, (bf16*)(ws + WS_H), (float*)(ws + WS_SS)};
            pg8::gemm_phase<pg8::EpiResidN, pg8::StaticOrder, false, true, true>(lds + RING_OFF, g, S, E);
        }
        SEAM(pb + 5);
        for (int rep = 0; rep < REP_MI; ++rep) if ((PHMASK & 128) && IN(pb + 6)) {
            PHASE_LOCALS();
            pg8::Gemm g{(const bf16*)(ws + WS_H), (const bf16*)(ws + WS_WMI) + (size_t)l * 8192 * 2048, pg8::TOK, 8192, 2048, 2048, 2048}; pg8::StaticOrder S; S.init(pg8::TOK, 8192, G, bx);
            pg8::EpiRelu2 E{(bf16*)(ws + WS_U)};
            pg8::gemm_phase<pg8::EpiRelu2, pg8::StaticOrder, true, true>(lds + RING_OFF, g, S, E);
        }
        SEAM(pb + 6);
        if ((PHMASK & 256) && IN(pb + 7)) {
            PHASE_LOCALS();
            pg8::Gemm g{(const bf16*)(ws + WS_U), (const bf16*)(ws + WS_WMO) + (size_t)l * 2048 * 8192, pg8::TOK, 2048, 8192, 8192, 8192}; pg8::StaticOrder S; S.init(pg8::TOK, 2048, G, bx);
            const int last = (l + 1 == DEPTH);
            pg8::EpiResidSX E{(float*)(ws + WS_X), (const float*)(ws + WS_SS), (float*)(ws + WS_XCH), (unsigned*)(ws + WS_CTL) + CW_CNT + 64 * 32 * l, last ? as_global(args.in[12]) : as_global(args.in[10]) + (l + 1) * DM,
                              (bf16*)(ws + WS_H), ws + WS_H8, as_global(args.out), last};
            pg8::gemm_phase<pg8::EpiResidSX, pg8::StaticOrder, false, true>(lds + RING_OFF, g, S, E);
        }
        if (l + 1 < DEPTH) SEAM(pb + 7);
    }
#undef IN
#undef SEAM
}

#ifndef MK_PER_PHASE
#define MK_PER_PHASE 0
#endif
extern "C" void kernel_launch(void* const* d_in, const int* in_sizes, int n_in, void* d_out, int out_size, void* d_ws, size_t ws_size, hipStream_t stream) {
    static int grid = 0;
    if (grid == 0) {
        if (n_in != 14 || out_size != pg8::TOK * DM || ws_size < WS_END) { fprintf(stderr, "kernel_launch: unexpected shapes (n_in %d, out %d, ws %zu < %zu); nothing launched\n", n_in, out_size, ws_size, (size_t)WS_END); grid = -1; return; }
        int dev = 0, cus = 0, per_cu = 0;
        if (hipGetDevice(&dev) != hipSuccess || hipDeviceGetAttribute(&cus, hipDeviceAttributeMultiprocessorCount, dev) != hipSuccess) { grid = -1; return; }
        if (hipFuncSetAttribute((const void*)trunk_fwd, hipFuncAttributeMaxDynamicSharedMemorySize, LDS_BYTES) != hipSuccess) { fprintf(stderr, "kernel_launch: hipFuncSetAttribute failed\n"); grid = -1; return; }
        if (hipOccupancyMaxActiveBlocksPerMultiprocessor(&per_cu, (const void*)trunk_fwd, NWAVES * 64, LDS_BYTES) != hipSuccess || per_cu < 1)
            fprintf(stderr, "kernel_launch: note: occupancy query reports %d workgroups per CU\n", per_cu);
        (void)hipGetLastError();
        grid = cus;
    }
    if (grid < 0) return;
    if (hipMemsetAsync((char*)d_ws + WS_CTL, 0, CTL_ZERO_BYTES, stream) != hipSuccess) { fprintf(stderr, "kernel_launch: memset failed\n"); return; }
    Args a{};
    for (int i = 0; i < 14; ++i) a.in[i] = (const float*)d_in[i];
    a.out = (float*)d_out; a.ws = (unsigned char*)d_ws; a.pad = 0;
#if MK_PER_PHASE
    for (int p = 0; p < N_PHASES - 1; ++p) { a.ph_lo = p; a.ph_hi = p + 1; a.use_bar = 0; hipLaunchKernelGGL(trunk_fwd, dim3(grid), dim3(NWAVES * 64), LDS_BYTES, stream, a); }
#else
    a.ph_lo = 0; a.ph_hi = N_PHASES; a.use_bar = 1;
    hipLaunchKernelGGL(trunk_fwd, dim3(grid), dim3(NWAVES * 64), LDS_BYTES, stream, a);
#endif
    const hipError_t le = hipPeekAtLastError();
    if (le != hipSuccess) fprintf(stderr, "kernel_launch: launch failed: %s\n", hipGetErrorName(le));
}
```
